# Optimizing an MI355X kernel written in HIP

```python
import jax, jax.numpy as jnp
from jax import lax
import numpy as np

D_MODEL = 2048
BATCH = 4
SEQ = 4096
DEPTH = 4
DEC_BATCH = 16
DEC_SEQ = 32
PAST_LEN = 4096

CHUNK = 64
N_A_LAYERS = DEPTH // 2
N_B_LAYERS = DEPTH - N_A_LAYERS
POOL_WINDOWS = (2, 4, 8, 16)
N_POOL_GROUPS = len(POOL_WINDOWS)
POOL_GROUP = D_MODEL // N_POOL_GROUPS
POOL_STATE = max(POOL_WINDOWS) - 1
HEAD_DIM = 64
N_HEADS = D_MODEL // HEAD_DIM
N_KV_HEADS = N_HEADS // 8
GQA_GROUP = N_HEADS // N_KV_HEADS
WINDOW = 128
WINDOW_CHUNKS = WINDOW // CHUNK
D_FF = 4 * D_MODEL
ROPE_THETA = 10000.0
EPS = 1e-6
ATTN_SCALE = HEAD_DIM ** -0.5
NEG_INF = -1e30

kernel_name = 'pool_swa_sink_yoco_stream'


def rmsnorm(x, g):
    xf = x.astype(jnp.float32)
    y = xf * lax.rsqrt(jnp.mean(xf * xf, axis=-1, keepdims=True) + EPS)
    return (y * g.astype(jnp.float32)).astype(x.dtype)


def modulate(x, shift, scale):
    return x * (1 + scale[:, None, :]) + shift[:, None, :]


def rope(x, pos):
    half = HEAD_DIM // 2
    inv = ROPE_THETA ** (-jnp.arange(half, dtype=jnp.float32) / half)
    ang = pos.astype(jnp.float32)[:, None] * inv[None, :]
    cos = jnp.cos(ang)[None, :, None, :]
    sin = jnp.sin(ang)[None, :, None, :]
    x1 = x[..., :half].astype(jnp.float32)
    x2 = x[..., half:].astype(jnp.float32)
    return jnp.concatenate([x1 * cos - x2 * sin, x2 * cos + x1 * sin], axis=-1).astype(x.dtype)


def pool_mix(h_ext, pos0, w_pool, pool_scale):
    B, L, D = h_ext.shape
    T = L - POOL_STATE
    hf = h_ext.astype(jnp.float32)
    cs = jnp.concatenate([jnp.zeros_like(hf[:, :1]), jnp.cumsum(hf, axis=1)], axis=1)
    end = cs[:, POOL_STATE + 1:]
    x_new = hf[:, POOL_STATE:]
    pos = pos0 + jnp.arange(T)
    outs = []
    for g, w in enumerate(POOL_WINDOWS):
        sl = slice(g * POOL_GROUP, (g + 1) * POOL_GROUP)
        start = cs[:, POOL_STATE + 1 - w:POOL_STATE + 1 - w + T, sl]
        cnt = jnp.minimum(w, pos + 1).astype(jnp.float32)[None, :, None]
        outs.append((end[..., sl] - start) / cnt - x_new[..., sl])
    pooled = jnp.stack(outs, axis=2).astype(h_ext.dtype)
    y = jnp.einsum('btgc,gcd->btgd', pooled, w_pool).reshape(B, T, D)
    return y * pool_scale


def sink_softmax(s, sink):
    sink = sink.astype(jnp.float32)
    m = jnp.maximum(jnp.max(s, axis=-1, keepdims=True), sink)
    e = jnp.exp(s - m)
    return e / (jnp.sum(e, axis=-1, keepdims=True) + jnp.exp(sink - m))


def attn_prompt(q, k, v, sink):
    B, S = q.shape[0], q.shape[1]
    n = S // CHUNK
    span = (WINDOW_CHUNKS + 1) * CHUNK
    pad = ((0, 0), (WINDOW_CHUNKS * CHUNK, 0), (0, 0), (0, 0))
    kc = jnp.pad(k, pad).reshape(B, n + WINDOW_CHUNKS, CHUNK, N_KV_HEADS, HEAD_DIM)
    vc = jnp.pad(v, pad).reshape(B, n + WINDOW_CHUNKS, CHUNK, N_KV_HEADS, HEAD_DIM)
    kb = jnp.concatenate([kc[:, i:i + n] for i in range(WINDOW_CHUNKS + 1)], axis=2)
    vb = jnp.concatenate([vc[:, i:i + n] for i in range(WINDOW_CHUNKS + 1)], axis=2)
    kpos = (jnp.arange(n)[:, None] - WINDOW_CHUNKS) * CHUNK + jnp.arange(span)[None, :]
    valid = kpos >= 0
    qb = q.reshape(B, n, CHUNK, N_KV_HEADS, GQA_GROUP, HEAD_DIM)
    s = jnp.einsum('bnqkgd,bnskd->bnkgqs', qb, kb, preferred_element_type=jnp.float32) * ATTN_SCALE
    s = jnp.where(valid[None, :, None, None, None, :], s, NEG_INF)
    p = sink_softmax(s, sink.reshape(N_KV_HEADS, GQA_GROUP)[None, None, :, :, None, None])
    o = jnp.einsum('bnkgqs,bnskd->bnqkgd', p.astype(v.dtype), vb)
    return o.reshape(B, S, N_HEADS * HEAD_DIM)


def attn_sample(q, k_new, v_new, k_past, v_past, sink):
    B, T = q.shape[0], q.shape[1]
    k = jnp.concatenate([k_past, k_new], axis=1)
    v = jnp.concatenate([v_past, v_new], axis=1)
    qg = q.reshape(B, T, N_KV_HEADS, GQA_GROUP, HEAD_DIM)
    s = jnp.einsum('btkgd,bskd->bkgts', qg, k, preferred_element_type=jnp.float32) * ATTN_SCALE
    p = sink_softmax(s, sink.reshape(N_KV_HEADS, GQA_GROUP)[None, :, :, None, None])
    o = jnp.einsum('bkgts,bskd->btkgd', p.astype(v.dtype), v)
    return o.reshape(B, T, N_HEADS * HEAD_DIM)


def shared_kv(x, c, pos, w_kv_mod, b_kv_mod, g_kv, w_kv):
    B, T, _ = x.shape
    mod = jax.nn.silu(c) @ w_kv_mod + b_kv_mod
    shift, scale = jnp.split(mod, 2, axis=-1)
    h = modulate(rmsnorm(x, g_kv), shift, scale)
    kv = h @ w_kv
    k, v = jnp.split(kv, 2, axis=-1)
    k = rope(k.reshape(B, T, N_KV_HEADS, HEAD_DIM), pos)
    v = v.reshape(B, T, N_KV_HEADS, HEAD_DIM)
    return k, v


def run_trunk(x, c, pos0, pool_prefix, kv_past, w_mod, b_mod, g_norm, w_pool, pool_scale,
              w_kv_mod, b_kv_mod, g_kv, w_kv, w_q, sinks, w_o, w_up, w_down):
    B, T, _ = x.shape
    pos = pos0 + jnp.arange(T)
    sc = jax.nn.silu(c)
    new_pool = []
    k = v = None
    for l in range(DEPTH):
        mod = sc @ w_mod[l] + b_mod[l]
        sh1, sc1, gt1, sh2, sc2, gt2 = jnp.split(mod, 6, axis=-1)
        h = modulate(rmsnorm(x, g_norm[l, 0]), sh1, sc1)
        if l < N_A_LAYERS:
            h_ext = jnp.concatenate([pool_prefix[l], h], axis=1)
            new_pool.append(h_ext[:, -POOL_STATE:])
            mix = pool_mix(h_ext, pos0, w_pool[l], pool_scale[l])
        else:
            j = l - N_A_LAYERS
            q = rope((h @ w_q[j]).reshape(B, T, N_HEADS, HEAD_DIM), pos)
            if kv_past is None:
                o = attn_prompt(q, k, v, sinks[j])
            else:
                o = attn_sample(q, k, v, kv_past[0], kv_past[1], sinks[j])
            mix = o @ w_o[j]
        x = x + gt1[:, None, :] * rmsnorm(mix, g_norm[l, 1])
        h = modulate(rmsnorm(x, g_norm[l, 2]), sh2, sc2)
        f = jnp.square(jax.nn.relu(h @ w_up[l])) @ w_down[l]
        x = x + gt2[:, None, :] * rmsnorm(f, g_norm[l, 3])
        if l == N_A_LAYERS - 1:
            k, v = shared_kv(x, c, pos, w_kv_mod, b_kv_mod, g_kv, w_kv)
    return x, jnp.stack(new_pool, axis=0), k, v


def setup_inputs(seed: int = 0) -> dict:
    key = jax.random.key(seed)
    ks = jax.random.split(key, 24)
    f32 = jnp.float32
    nrm = lambda k, shape, s: jax.random.normal(k, shape, f32) * s
    D = D_MODEL
    kv_rows = min(WINDOW, PAST_LEN)
    return {
        'x_prompt': nrm(ks[0], (BATCH, SEQ, D), 1.0),
        'x_sample': nrm(ks[1], (DEC_BATCH, DEC_SEQ, D), 1.0),
        'c_prompt': nrm(ks[2], (BATCH, D), 1.0),
        'c_sample': nrm(ks[3], (DEC_BATCH, D), 1.0),
        'state_pool': nrm(ks[4], (N_A_LAYERS, DEC_BATCH, POOL_STATE, D), 1.0),
        'cache_k': nrm(ks[5], (DEC_BATCH, kv_rows, N_KV_HEADS, HEAD_DIM), 1.0),
        'cache_v': nrm(ks[6], (DEC_BATCH, kv_rows, N_KV_HEADS, HEAD_DIM), 1.0),
        'w_mod': nrm(ks[7], (DEPTH, D, 6 * D), D ** -0.5),
        'b_mod': nrm(ks[8], (DEPTH, 6 * D), 0.02),
        'g_norm': 1.0 + nrm(ks[9], (DEPTH, 4, D), 0.02),
        'w_pool': nrm(ks[10], (N_A_LAYERS, N_POOL_GROUPS, POOL_GROUP, POOL_GROUP), POOL_GROUP ** -0.5),
        'pool_scale': 1.0 + nrm(ks[11], (N_A_LAYERS, D), 0.1),
        'w_kv_mod': nrm(ks[12], (D, 2 * D), D ** -0.5),
        'b_kv_mod': nrm(ks[13], (2 * D,), 0.02),
        'g_kv': 1.0 + nrm(ks[14], (D,), 0.02),
        'w_kv': nrm(ks[15], (D, 2 * N_KV_HEADS * HEAD_DIM), D ** -0.5),
        'w_q': nrm(ks[16], (N_B_LAYERS, D, N_HEADS * HEAD_DIM), D ** -0.5),
        'sinks': nrm(ks[17], (N_B_LAYERS, N_HEADS), 0.5),
        'w_o': nrm(ks[18], (N_B_LAYERS, N_HEADS * HEAD_DIM, D), (N_HEADS * HEAD_DIM) ** -0.5),
        'w_up': nrm(ks[19], (DEPTH, D, D_FF), D ** -0.5),
        'w_down': nrm(ks[20], (DEPTH, D_FF, D), D_FF ** -0.5),
    }


def reference(x_prompt, x_sample, c_prompt, c_sample, state_pool, cache_k, cache_v,
              w_mod, b_mod, g_norm, w_pool, pool_scale, w_kv_mod, b_kv_mod, g_kv, w_kv,
              w_q, sinks, w_o, w_up, w_down):
    prompt_prefix = jnp.zeros((N_A_LAYERS, x_prompt.shape[0], POOL_STATE, D_MODEL), x_prompt.dtype)
    y_prompt, pool_p, k_p, v_p = run_trunk(
        x_prompt, c_prompt, 0, prompt_prefix, None, w_mod, b_mod, g_norm, w_pool, pool_scale,
        w_kv_mod, b_kv_mod, g_kv, w_kv, w_q, sinks, w_o, w_up, w_down)
    y_sample, pool_s, k_s, v_s = run_trunk(
        x_sample, c_sample, PAST_LEN, state_pool, (cache_k, cache_v), w_mod, b_mod, g_norm, w_pool,
        pool_scale, w_kv_mod, b_kv_mod, g_kv, w_kv, w_q, sinks, w_o, w_up, w_down)
    kv_keep = min(WINDOW, x_prompt.shape[1])
    new_k_prompt = k_p[:, -kv_keep:]
    new_v_prompt = v_p[:, -kv_keep:]
    return (y_prompt, y_sample, pool_p, pool_s, new_k_prompt, new_v_prompt, k_s, v_s)
```

```cpp
#include <hip/hip_runtime.h>
#include <cstdio>
#include <cstdint>

#ifndef MK_MULTI
#define MK_MULTI 0
#endif

constexpr int D = 2048, FF = 8192, NSEQ = 20, MP = 16384, MS = 512, M = MP + MS, SEQ = 4096, DSEQ = 32, NBP = 4, NBS = 16;
constexpr int DEPTH = 4, NA = 2, HD = 64, NH = 32, NKV = 4, KVW = NKV * HD  , SKEYS = 160  ;
constexpr int MODW = 6 * D;
constexpr float EPS = 1e-6f;
constexpr float QSCALE = 0.125f * 1.4426950408889634f;
constexpr float LOG2E = 1.4426950408889634f;
constexpr int NPOS = SEQ + DSEQ;

constexpr size_t O_Y = 0, O_PP = (size_t)M * D, O_PS = O_PP + (size_t)NA * NBP * 15 * D, O_KP = O_PS + (size_t)NA * NBS * 15 * D,
                 O_VP = O_KP + (size_t)NBP * 128 * KVW, O_KS = O_VP + (size_t)NBP * 128 * KVW, O_VS = O_KS + (size_t)NBS * DSEQ * KVW, O_END = O_VS + (size_t)NBS * DSEQ * KVW;

constexpr size_t MiB = 1u << 20;
constexpr size_t WS_CTL = 0, CTL_ZERO_BYTES = 1 * MiB;
constexpr size_t WS_MOD = 2 * MiB;
constexpr size_t WS_KVMOD = WS_MOD + (size_t)DEPTH * NSEQ * MODW * 4;
constexpr size_t WS_ROPE = 7 * MiB;
constexpr size_t WS_RSTD = 9 * MiB;
constexpr size_t WS_KS = 10 * MiB;
constexpr size_t WS_VTS = 12 * MiB;
constexpr size_t WS_KP = 16 * MiB;
constexpr size_t WS_VTP = 24 * MiB;
constexpr size_t WS_WPOOL = 32 * MiB;
constexpr size_t WS_WKV = 36 * MiB;
constexpr size_t WS_WQ = 40 * MiB;
constexpr size_t WS_WO = 56 * MiB;
constexpr size_t WS_WUP = 72 * MiB;
constexpr size_t WS_WDN = 200 * MiB;
constexpr size_t WS_H = 328 * MiB;
constexpr size_t WS_Q = 394 * MiB;
constexpr size_t WS_Y = 460 * MiB;
constexpr size_t WS_HKV = 526 * MiB;
constexpr size_t WS_U = 592 * MiB;
constexpr size_t WS_END = 856 * MiB;
static_assert(WS_KVMOD + (size_t)NSEQ * 4096 * 4 <= WS_ROPE, "ws map");
static_assert(WS_ROPE + (size_t)NPOS * 32 * 8 <= WS_RSTD, "ws map");

constexpr int CW_BAR = 4096;

constexpr int RING_BYTES = 131072, LDSCTL_OFF = RING_BYTES, MISC_OFF = LDSCTL_OFF + 320, LDS_BYTES = 147456;
constexpr int NWAVES = 8;

#define GAS __attribute__((address_space(1)))
#define LAS __attribute__((address_space(3)))
typedef unsigned short bf16_t;
typedef short bf16x8 __attribute__((ext_vector_type(8)));
typedef float f32x4 __attribute__((ext_vector_type(4)));
typedef float f32x2 __attribute__((ext_vector_type(2)));
typedef unsigned u32x4 __attribute__((ext_vector_type(4)));
typedef unsigned u32x2 __attribute__((ext_vector_type(2)));

__device__ __forceinline__ unsigned cvt_pk_bf16(float lo, float hi) { unsigned r; asm volatile("v_cvt_pk_bf16_f32 %0, %1, %2" : "=v"(r) : "v"(lo), "v"(hi)); return r; }
__device__ __forceinline__ float bf_lo(unsigned w) { return __uint_as_float(w << 16); }
__device__ __forceinline__ float bf_hi(unsigned w) { return __uint_as_float(w & 0xffff0000u); }
__device__ __forceinline__ int fresh_tid(int wave_s) { int t = wave_s * 64 + (int)__builtin_amdgcn_mbcnt_hi(~0u, __builtin_amdgcn_mbcnt_lo(~0u, 0u)); asm volatile("" : "+v"(t)); return t; }
__device__ __forceinline__ float wave_sum(float v) {
#pragma unroll
    for (int o = 1; o < 64; o <<= 1) v += __shfl_xor(v, o);
    return v;
}

namespace pg8 {
constexpr int BM = 256, BK = 64, HALF = 128, HTB = HALF * BK * 2, STAGE_BYTES = 8 * HTB, NXCD = 8, WGM = 8;
__host__ __device__ __forceinline__ int lds_byte(int r, int c) { const int st = (r >> 4) * 2 + (c >> 5), rr = r & 15, cc = c & 31, ob = rr * 64 + cc * 2; return st * 1024 + (ob ^ (((ob >> 9) & 1) << 5)); }
__host__ __device__ __forceinline__ void stage_rc(int b, int& R, int& C) { const int st = b / 1024, sb = b % 1024, swz = sb ^ (((sb >> 9) & 1) << 5); R = (st >> 1) * 16 + swz / 64; C = (st & 1) * 32 + (swz % 64) / 2; }
__host__ __device__ __forceinline__ int perm32(int rho) { const int n = rho >> 4, i = rho & 15; return 8 * (i >> 2) + 4 * n + (i & 3); }

struct Unit { const char* pa; const char* pb; int nt, pm, pn, kind; };

__device__ __forceinline__ bool tile_of(int i, int G, int c, int nM, int nN, int& pm, int& pn) {
    const int nwg = nM * nN; const long L = (long)i * G + c; if (L >= nwg) return false;
    int wgid = (int)L; { const int q = nwg / NXCD, r = nwg % NXCD, xcd = wgid % NXCD, off = wgid / NXCD; wgid = (xcd < r ? xcd * (q + 1) : r * (q + 1) + (xcd - r) * q) + off; }
    const int nig = WGM * nN, gid = wgid / nig, fm = gid * WGM, gsz = (nM - fm) < WGM ? (nM - fm) : WGM;
    pm = fm + ((wgid % nig) % gsz); pn = (wgid % nig) / gsz; return true;
}

template <class Epi, class Sched>
__device__ __forceinline__ void gemm_phase(LAS unsigned char* lds, const int wave_s, const int lda, const int ldb, const Sched& S, const Epi& E) {
    const int tid = fresh_tid(wave_s), wid = __builtin_amdgcn_readfirstlane(tid >> 6), lane = tid & 63, wr = wid >> 2, wc = wid & 3, fr = lane & 15, fq = lane >> 4;
    unsigned voffA[2], voffB[2];
#pragma unroll
    for (int i = 0; i < 2; ++i) { int R, C; stage_rc(tid * 16 + i * 8192, R, C); const int Rb = (R & ~31) + perm32(R & 31);
        voffA[i] = (unsigned)(R * lda + C) * 2u; voffB[i] = (unsigned)(Rb * ldb + C) * 2u; }
    const size_t kstep = (size_t)(BK * 2);
    const size_t hstepA = (size_t)HALF * lda * 2, hstepB = (size_t)HALF * ldb * 2;
    const unsigned ldsw = (unsigned)wid * 1024u;
    const int aoff = lds_byte(wr * 64 + fr, fq * 8), boff = lds_byte(wc * 32 + fr, fq * 8);
#define PG8_SA(b, h) (((b) * 2 + (h)) * HTB)
#define PG8_SB(b, h) ((4 + (b) * 2 + (h)) * HTB)
#define PG8_STAGE(bufoff, gbase, voff) do { _Pragma("unroll") for (int _i = 0; _i < 2; ++_i) \
        __builtin_amdgcn_global_load_lds((const unsigned*)((const char*)(gbase) + (voff)[_i]), (LAS unsigned*)(lds + (bufoff) + ldsw + _i * 8192), 16, 0, 0); } while (0)
#define PG8_LDA(dst, b, h) do { _Pragma("unroll") for (int m = 0; m < 4; ++m) _Pragma("unroll") for (int k = 0; k < 2; ++k) dst[m][k] = *(const LAS bf16x8*)(lds + PG8_SA(b, h) + aoff + m * 2048 + k * 1024); } while (0)
#define PG8_LDB(dst, b, h) do { _Pragma("unroll") for (int n = 0; n < 2; ++n) _Pragma("unroll") for (int k = 0; k < 2; ++k) dst[n][k] = *(const LAS bf16x8*)(lds + PG8_SB(b, h) + boff + n * 2048 + k * 1024); } while (0)
#define PG8_MMA(ai, bj, At, Bt) do { __builtin_amdgcn_s_setprio(1); _Pragma("unroll") for (int m = 0; m < 4; ++m) _Pragma("unroll") for (int n = 0; n < 2; ++n) _Pragma("unroll") for (int k = 0; k < 2; ++k) \
        acc[ai][bj][m][n] = __builtin_amdgcn_mfma_f32_16x16x32_bf16(Bt[n][k], At[m][k], acc[ai][bj][m][n], 0, 0, 0); __builtin_amdgcn_s_setprio(0); } while (0)
#define PG8_WAIT_V(n) asm volatile("s_waitcnt vmcnt(" #n ")" ::: "memory")
#define PG8_WAIT_L(n) asm volatile("s_waitcnt lgkmcnt(" #n ")" ::: "memory")
#define PG8_BAR __builtin_amdgcn_s_barrier()
#define PG8_SCHED __builtin_amdgcn_sched_barrier(0)
    Unit cur, nxt; int ui = 0;
    if (!S.next(0, cur)) return;
    f32x4 acc[2][2][4][2];
#pragma unroll
    for (int a = 0; a < 2; ++a)
#pragma unroll
        for (int b = 0; b < 2; ++b)
#pragma unroll
            for (int m = 0; m < 4; ++m)
#pragma unroll
                for (int n = 0; n < 2; ++n) acc[a][b][m][n] = (f32x4){0.f, 0.f, 0.f, 0.f};
    bf16x8 At[4][2], B0[2][2], B1[2][2];
    const char* cA = cur.pa; const char* cB = cur.pb;
    PG8_STAGE(PG8_SB(0, 0), cB, voffB); PG8_STAGE(PG8_SB(0, 1), cB + hstepB, voffB); PG8_STAGE(PG8_SA(0, 0), cA, voffA); PG8_STAGE(PG8_SA(0, 1), cA + hstepA, voffA);
    if (wr == 1) PG8_BAR;
    PG8_WAIT_V(2); PG8_BAR;
    PG8_STAGE(PG8_SB(1, 0), cB + kstep, voffB); PG8_STAGE(PG8_SA(1, 0), cA + kstep, voffA); PG8_STAGE(PG8_SB(1, 1), cB + hstepB + kstep, voffB);
    PG8_WAIT_V(6); PG8_BAR;
    for (;;) {
        const bool has_next = S.next(ui + 1, nxt);
        const char* nA = has_next ? nxt.pa : cA; const char* nB = has_next ? nxt.pb : cB;
        const int nt = cur.nt;
        for (int t = 0; t < nt; t += 2) {
            const bool last = (t == nt - 2);
            const char* a1 = cA + (size_t)(t + 1) * kstep;
            const char* a2 = last ? nA : cA + (size_t)(t + 2) * kstep; const char* b2 = last ? nB : cB + (size_t)(t + 2) * kstep;
            const char* a3 = a2 + kstep; const char* b3 = b2 + kstep;
            PG8_LDB(B0, 0, 0); PG8_LDB(B1, 0, 1); PG8_SCHED; PG8_LDA(At, 0, 0); PG8_STAGE(PG8_SA(1, 1), a1 + hstepA, voffA);
            PG8_WAIT_V(8); PG8_WAIT_L(0); PG8_BAR; PG8_MMA(0, 0, At, B0); PG8_MMA(0, 1, At, B1); PG8_BAR; PG8_SCHED;
            PG8_LDA(At, 0, 1); PG8_STAGE(PG8_SB(0, 0), b2, voffB); PG8_STAGE(PG8_SB(0, 1), b2 + hstepB, voffB); PG8_STAGE(PG8_SA(0, 0), a2, voffA);
            PG8_WAIT_V(8); PG8_WAIT_L(0); PG8_BAR; PG8_MMA(1, 0, At, B0); PG8_MMA(1, 1, At, B1); PG8_BAR; PG8_SCHED;
            PG8_LDB(B0, 1, 0); PG8_LDB(B1, 1, 1); PG8_SCHED; PG8_LDA(At, 1, 0); PG8_STAGE(PG8_SA(0, 1), a2 + hstepA, voffA);
            PG8_WAIT_V(8); PG8_WAIT_L(0); PG8_BAR; PG8_MMA(0, 0, At, B0); PG8_MMA(0, 1, At, B1); PG8_BAR; PG8_SCHED;
            PG8_LDA(At, 1, 1); PG8_STAGE(PG8_SB(1, 0), b3, voffB); PG8_STAGE(PG8_SB(1, 1), b3 + hstepB, voffB); PG8_STAGE(PG8_SA(1, 0), a3, voffA);
            PG8_WAIT_V(8); PG8_WAIT_L(0); PG8_BAR; PG8_MMA(1, 0, At, B0); PG8_MMA(1, 1, At, B1); PG8_BAR; PG8_SCHED;
        }
        if (wr == 0) PG8_BAR;
        E(acc, cur, wr, wc, fr, fq);
        if (!has_next) break;
#pragma unroll
        for (int a = 0; a < 2; ++a)
#pragma unroll
            for (int b = 0; b < 2; ++b)
#pragma unroll
                for (int m = 0; m < 4; ++m)
#pragma unroll
                    for (int n = 0; n < 2; ++n) acc[a][b][m][n] = (f32x4){0.f, 0.f, 0.f, 0.f};
        cur = nxt; cA = nA; cB = nB; ++ui;
        if (wr == 1) PG8_BAR;
    }
    PG8_WAIT_V(0);
    PG8_BAR;
#undef PG8_SA
#undef PG8_SB
#undef PG8_STAGE
#undef PG8_LDA
#undef PG8_LDB
#undef PG8_MMA
#undef PG8_WAIT_V
#undef PG8_WAIT_L
#undef PG8_BAR
#undef PG8_SCHED
}

struct SchedMN {
    const char* A; const char* Bt; int lda, ldb, nM, nN, nt, G, c;
    __device__ __forceinline__ bool next(int i, Unit& u) const {
        int pm, pn; if (!tile_of(i, G, c, nM, nN, pm, pn)) return false;
        u.pa = A + (size_t)pm * BM * lda * 2; u.pb = Bt + (size_t)pn * BM * ldb * 2; u.nt = nt; u.pm = pm; u.pn = pn; u.kind = 0; return true;
    }
};
struct SchedPool {
    const char* A; const char* Bt; int nM, G, c;
    __device__ __forceinline__ bool next(int i, Unit& u) const {
        int pm, pn; if (!tile_of(i, G, c, nM, 8, pm, pn)) return false;
        u.pa = A + ((size_t)pm * BM * D + (size_t)(pn >> 1) * 512) * 2; u.pb = Bt + (size_t)pn * BM * 512 * 2; u.nt = 8; u.pm = pm; u.pn = pn; u.kind = 0; return true;
    }
};
struct SchedQKV {
    const char* wsb; int j, nM, nN, G, c;
    __device__ __forceinline__ bool next(int i, Unit& u) const {
        int pm, pn; if (!tile_of(i, G, c, nM, nN, pm, pn)) return false;
        if (pn < 8) { u.pa = wsb + WS_H + (size_t)pm * BM * D * 2; u.pb = wsb + WS_WQ + ((size_t)j * D + (size_t)pn * BM) * D * 2; u.kind = 0; u.pn = pn; }
        else { u.pa = wsb + WS_HKV + (size_t)pm * BM * D * 2; u.pb = wsb + WS_WKV + (size_t)(pn - 8) * BM * D * 2; u.kind = pn - 7; u.pn = pn - 8; }
        u.nt = D / BK; u.pm = pm; return true;
    }
};

template <int ACT  > struct EpiBf16 {
    bf16_t* O; int ldc; const float* cs;
    __device__ __forceinline__ void operator()(const f32x4 (&acc)[2][2][4][2], const Unit& u, int wr, int wc, int fr, int fq) const {
        const int row0 = u.pm * BM + wr * 64 + fr, col0 = u.pn * BM + wc * 32 + 8 * fq;
        f32x4 sv[2][2];
        if (ACT == 2) {
#pragma unroll
            for (int bj = 0; bj < 2; ++bj)
#pragma unroll
                for (int n = 0; n < 2; ++n) sv[bj][n] = *(const f32x4*)(cs + col0 + bj * HALF + 4 * n);
        }
#pragma unroll
        for (int ai = 0; ai < 2; ++ai)
#pragma unroll
            for (int m = 0; m < 4; ++m) { bf16_t* rowp = O + (size_t)(row0 + ai * HALF + m * 16) * ldc + col0;
#pragma unroll
                for (int bj = 0; bj < 2; ++bj) { f32x4 v0 = acc[ai][bj][m][0], v1 = acc[ai][bj][m][1];
                    if (ACT == 1) {
#pragma unroll
                        for (int e = 0; e < 4; ++e) { const float a = fmaxf(v0[e], 0.f), b = fmaxf(v1[e], 0.f); v0[e] = a * a; v1[e] = b * b; } }
                    if (ACT == 2) { v0 = v0 * sv[bj][0]; v1 = v1 * sv[bj][1]; }
                    u32x4 w; w.x = cvt_pk_bf16(v0[0], v0[1]); w.y = cvt_pk_bf16(v0[2], v0[3]); w.z = cvt_pk_bf16(v1[0], v1[1]); w.w = cvt_pk_bf16(v1[2], v1[3]);
                    *(u32x4*)(rowp + bj * HALF) = w; } }
    }
};

struct EpiQKV {
    unsigned char* wsb; float* out;
    __device__ __forceinline__ void operator()(const f32x4 (&acc)[2][2][4][2], const Unit& u, int wr, int wc, int fr, int fq) const {
        bf16_t* const Q = (bf16_t*)(wsb + WS_Q); const float* const rope = (const float*)(wsb + WS_ROPE); bf16_t* const KP = (bf16_t*)(wsb + WS_KP); bf16_t* const KS = (bf16_t*)(wsb + WS_KS);
        bf16_t* const VTP = (bf16_t*)(wsb + WS_VTP); bf16_t* const VTS = (bf16_t*)(wsb + WS_VTS);
#pragma unroll
        for (int ai = 0; ai < 2; ++ai)
#pragma unroll
            for (int m = 0; m < 4; ++m) {
                const int r = u.pm * BM + ai * HALF + wr * 64 + m * 16 + fr;
                const bool prompt = r < MP;
                const int b = prompt ? (r >> 12) : ((r - MP) >> 5), t = prompt ? (r & 4095) : ((r - MP) & 31), pos = prompt ? t : SEQ + t;
                if (u.kind != 2) {
                    const f32x4* cp = (const f32x4*)(rope + ((size_t)pos * 32 + 8 * fq) * 2);
                    const f32x4 f0 = cp[0], f1 = cp[1], f2 = cp[2], f3 = cp[3];
                    const float cs_[8] = {f0[0], f0[2], f1[0], f1[2], f2[0], f2[2], f3[0], f3[2]};
                    const float sn_[8] = {f0[1], f0[3], f1[1], f1[3], f2[1], f2[3], f3[1], f3[3]};
                    float o1[8], o2[8];
#pragma unroll
                    for (int n = 0; n < 2; ++n)
#pragma unroll
                        for (int e = 0; e < 4; ++e) { const int k = 4 * n + e; const float x1 = acc[ai][0][m][n][e], x2 = acc[ai][1][m][n][e];
                            o1[k] = x1 * cs_[k] - x2 * sn_[k]; o2[k] = x2 * cs_[k] + x1 * sn_[k]; }
                    if (u.kind == 0) {
                        bf16_t* qp = Q + (size_t)r * D + u.pn * BM + wc * 64 + 8 * fq;
                        u32x4 w1, w2;
                        w1.x = cvt_pk_bf16(o1[0] * QSCALE, o1[1] * QSCALE); w1.y = cvt_pk_bf16(o1[2] * QSCALE, o1[3] * QSCALE); w1.z = cvt_pk_bf16(o1[4] * QSCALE, o1[5] * QSCALE); w1.w = cvt_pk_bf16(o1[6] * QSCALE, o1[7] * QSCALE);
                        w2.x = cvt_pk_bf16(o2[0] * QSCALE, o2[1] * QSCALE); w2.y = cvt_pk_bf16(o2[2] * QSCALE, o2[3] * QSCALE); w2.z = cvt_pk_bf16(o2[4] * QSCALE, o2[5] * QSCALE); w2.w = cvt_pk_bf16(o2[6] * QSCALE, o2[7] * QSCALE);
                        *(u32x4*)qp = w1; *(u32x4*)(qp + 32) = w2;
                    } else {
                        const int col = wc * 64 + 8 * fq;
                        bf16_t* kp = prompt ? KP + (size_t)r * KVW + col : KS + ((size_t)b * SKEYS + 128 + t) * KVW + col;
                        u32x4 w1, w2;
                        w1.x = cvt_pk_bf16(o1[0], o1[1]); w1.y = cvt_pk_bf16(o1[2], o1[3]); w1.z = cvt_pk_bf16(o1[4], o1[5]); w1.w = cvt_pk_bf16(o1[6], o1[7]);
                        w2.x = cvt_pk_bf16(o2[0], o2[1]); w2.y = cvt_pk_bf16(o2[2], o2[3]); w2.z = cvt_pk_bf16(o2[4], o2[5]); w2.w = cvt_pk_bf16(o2[6], o2[7]);
                        *(u32x4*)kp = w1; *(u32x4*)(kp + 32) = w2;
                        float* fo = nullptr;
                        if (prompt) { if (t >= SEQ - 128) fo = out + O_KP + ((size_t)b * 128 + (t - (SEQ - 128))) * KVW + col; }
                        else fo = out + O_KS + (size_t)(r - MP) * KVW + col;
                        if (fo) { *(f32x4*)fo = (f32x4){o1[0], o1[1], o1[2], o1[3]}; *(f32x4*)(fo + 4) = (f32x4){o1[4], o1[5], o1[6], o1[7]};
                                  *(f32x4*)(fo + 32) = (f32x4){o2[0], o2[1], o2[2], o2[3]}; *(f32x4*)(fo + 36) = (f32x4){o2[4], o2[5], o2[6], o2[7]}; }
                    }
                } else {
#pragma unroll
                    for (int bj = 0; bj < 2; ++bj) {
                        const int col = bj * HALF + wc * 32 + 8 * fq;
                        const int kh = col >> 6, d0 = col & 63;
                        bf16_t* vt = prompt ? VTP + ((size_t)(b * NKV + kh) * HD + d0) * SEQ + t : VTS + ((size_t)(b * NKV + kh) * HD + d0) * SKEYS + 128 + t;
                        const size_t vstr = prompt ? SEQ : SKEYS;
                        const f32x4 v0 = acc[ai][bj][m][0], v1 = acc[ai][bj][m][1];
                        const unsigned p0 = cvt_pk_bf16(v0[0], v0[1]), p1 = cvt_pk_bf16(v0[2], v0[3]), p2 = cvt_pk_bf16(v1[0], v1[1]), p3 = cvt_pk_bf16(v1[2], v1[3]);
                        vt[0 * vstr] = (bf16_t)(p0 & 0xffff); vt[1 * vstr] = (bf16_t)(p0 >> 16); vt[2 * vstr] = (bf16_t)(p1 & 0xffff); vt[3 * vstr] = (bf16_t)(p1 >> 16);
                        vt[4 * vstr] = (bf16_t)(p2 & 0xffff); vt[5 * vstr] = (bf16_t)(p2 >> 16); vt[6 * vstr] = (bf16_t)(p3 & 0xffff); vt[7 * vstr] = (bf16_t)(p3 >> 16);
                        float* fo = nullptr;
                        if (prompt) { if (t >= SEQ - 128) fo = out + O_VP + ((size_t)b * 128 + (t - (SEQ - 128))) * KVW + col; }
                        else fo = out + O_VS + (size_t)(r - MP) * KVW + col;
                        if (fo) { *(f32x4*)fo = v0; *(f32x4*)(fo + 4) = v1; }
                    }
                }
            }
    }
};
}

#define XB_TMO      128
#define XB_XCNT(j)  (256  + 64 * (j))
#define XB_XSUB(j)  (1280 + 64 * (j))
#define XB_XGEN(j)  (2304 + 64 * (j))
#define XB_TOP      3328
#define XB_TOPGEN   3392
#define XCD_BAR_WORDS 3456
#define XB_SPIN_CAP (1u << 18)

__device__ __forceinline__ unsigned xb_ld(unsigned* p)              { return __hip_atomic_load(p, __ATOMIC_RELAXED, __HIP_MEMORY_SCOPE_AGENT); }
__device__ __forceinline__ unsigned xb_add(unsigned* p, unsigned v) { return __hip_atomic_fetch_add(p, v, __ATOMIC_RELAXED, __HIP_MEMORY_SCOPE_AGENT); }
__device__ __forceinline__ unsigned xb_xcc_id() { return (unsigned)__builtin_amdgcn_s_getreg((3 << 11) | 20) & 0xFu; }
#define XB_SPIN(cond, bar) do { unsigned _sp = 0; while (cond) { __builtin_amdgcn_s_sleep(1); \
    if ((++_sp & 255u) == 0u) { if (xb_ld(&(bar)[XB_TMO])) break; if (_sp > XB_SPIN_CAP) { atomicAdd(&(bar)[XB_TMO], 1u); break; } } } } while (0)

struct XcdBarrier { unsigned* bar; unsigned x; volatile LAS unsigned* st; };

__device__ __forceinline__ XcdBarrier xcd_barrier_post(unsigned* bar, volatile LAS unsigned* st) {
    XcdBarrier b; b.bar = bar; b.x = xb_xcc_id(); b.st = st;
    if (threadIdx.x == 0) (void)xb_add(&bar[XB_XCNT(b.x)], 1u);
    return b;
}
__device__ __forceinline__ void xcd_barrier_complete(unsigned* bar, unsigned x, unsigned& nloc, unsigned& nx) {
    const unsigned G = gridDim.x * gridDim.y * gridDim.z;
    unsigned sum, cnt, mine, sp = 0u;
    for (;;) {
        sum = 0u; cnt = 0u; mine = 0u;
#pragma unroll
        for (unsigned j = 0; j < 16; ++j) { const unsigned c = xb_ld(&bar[XB_XCNT(j)]); sum += c; cnt += (c > 0u) ? 1u : 0u; mine = (j == x) ? c : mine; }
        if (sum == G) break;
        __builtin_amdgcn_s_sleep(1);
        if ((++sp & 255u) == 0u) { if (xb_ld(&bar[XB_TMO])) break; if (sp > XB_SPIN_CAP) { atomicAdd(&bar[XB_TMO], 1u); break; } }
    }
    nloc = mine > 0u ? mine : 1u; nx = cnt > 0u ? cnt : 1u;
}
__device__ __forceinline__ void xcd_barrier(const XcdBarrier& b) {
    asm volatile("s_waitcnt vmcnt(0)" ::: "memory");
    __syncthreads();
    if (threadIdx.x == 0) {
        unsigned* bar = b.bar;
        __builtin_amdgcn_s_waitcnt(0);
        unsigned nloc = b.st[0], nx = b.st[1];
        if (nloc == 0u) { xcd_barrier_complete(bar, b.x, nloc, nx); b.st[0] = nloc; b.st[1] = nx; }
        const unsigned old = xb_add(&bar[XB_XSUB(b.x)], 1u);
        const unsigned gen = old / nloc;
        if (old + 1u == (gen + 1u) * nloc) {
            __builtin_amdgcn_fence(__ATOMIC_RELEASE, "agent");
            asm volatile("s_waitcnt vmcnt(0)" ::: "memory");
            const unsigned og = xb_add(&bar[XB_TOP], 1u);
            const unsigned tg = og / nx;
            if (og + 1u == (tg + 1u) * nx) xb_add(&bar[XB_TOPGEN], 1u);
            else XB_SPIN(xb_ld(&bar[XB_TOPGEN]) == tg, bar);
            __builtin_amdgcn_fence(__ATOMIC_ACQUIRE, "agent");
            xb_add(&bar[XB_XGEN(b.x)], 1u);
            asm volatile("s_waitcnt vmcnt(0)" ::: "memory");
        } else {
            XB_SPIN(xb_ld(&bar[XB_XGEN(b.x)]) == gen, bar);
            __builtin_amdgcn_fence(__ATOMIC_ACQUIRE, "agent");
            asm volatile("s_waitcnt vmcnt(0)" ::: "memory");
        }
    }
    __syncthreads();
}

__device__ __forceinline__ int seq_of_row(int r) { return r < MP ? (r >> 12) : NBP + ((r - MP) >> 5); }

template <bool ROPEPERM>
__device__ __forceinline__ void p0_transpose_item(const float* W, int K, int N, bf16_t* WT, LAS float* scr, int item, int lane) {
    const int nblk = N / 32, kb = item / nblk, nb = item % nblk, k0 = 64 * kb, n0 = 32 * nb;
#pragma unroll 8
    for (int i = 0; i < 32; ++i) { const int kk = 2 * i + (lane >> 5); scr[kk * 33 + (lane & 31)] = W[(size_t)(k0 + kk) * N + n0 + (lane & 31)]; }
    asm volatile("s_waitcnt lgkmcnt(0)" ::: "memory");
    const int c = lane & 7;
#pragma unroll
    for (int j = 0; j < 4; ++j) { const int n = (lane >> 3) + 8 * j; const LAS float* s = scr + (8 * c) * 33 + n;
        u32x4 o; o.x = cvt_pk_bf16(s[0 * 33], s[1 * 33]); o.y = cvt_pk_bf16(s[2 * 33], s[3 * 33]); o.z = cvt_pk_bf16(s[4 * 33], s[5 * 33]); o.w = cvt_pk_bf16(s[6 * 33], s[7 * 33]);
        int nn = n0 + n;
        if (ROPEPERM) nn = (nn & ~255) + 128 * ((nn >> 5) & 1) + 32 * ((nn >> 6) & 3) + (nn & 31);
        *(u32x4*)(WT + (size_t)nn * K + k0 + 8 * c) = o; }
    asm volatile("s_waitcnt lgkmcnt(0)" ::: "memory");
}

struct Args { const float* in[21]; float* out; unsigned char* ws; int ph_lo, ph_hi; };

template <int W>
__device__ __forceinline__ void pool_item(const float* xs, const float* rstd, bf16_t* P, int t0, int tend, bool sample, const float* prefix, float* pool_out, int pool_t0, const f32x4 a, const f32x4 b, int c) {
    f32x4 ring[W];
#pragma unroll
    for (int i = 0; i < W; ++i) ring[i] = (f32x4){0.f, 0.f, 0.f, 0.f};
    f32x4 s = (f32x4){0.f, 0.f, 0.f, 0.f};
    const int tstart = sample ? -16 : (t0 >= 16 ? t0 - 16 : 0);
    for (int tb = tstart; tb < tend; tb += 16) {
#pragma unroll
        for (int i = 0; i < 16; ++i) {
            const int t = tb + i;
            f32x4 h;
            if (t < 0) { h = (t >= -15) ? *(const f32x4*)(prefix + (size_t)(t + 15) * D + c) : (f32x4){0.f, 0.f, 0.f, 0.f}; }
            else { const f32x4 xv = *(const f32x4*)(xs + (size_t)t * D + c); const float rs = rstd[t]; h = xv * rs * a + b; }
            s = s + h - ring[i % W]; ring[i % W] = h;
            if (t >= t0) {
                const float inv = sample ? (1.0f / W) : ((t + 1 < W) ? 1.0f / (float)(t + 1) : (1.0f / W));
                const f32x4 p = s * inv - h;
                u32x2 w; w.x = cvt_pk_bf16(p[0], p[1]); w.y = cvt_pk_bf16(p[2], p[3]);
                *(u32x2*)(P + (size_t)t * D + c) = w;
                if (t >= pool_t0) *(f32x4*)(pool_out + (size_t)(t - pool_t0) * D + c) = h;
            }
        }
    }
}

template <int NOUT>
__device__ __forceinline__ void row_phase(int wave, int lane, const bf16_t* Y, const float* xp, const float* xs, float* X,
                                          const float* gpost, const float* gate  , int gld,
                                          bf16_t* H0, const float* g0, const float* sh0, const float* sc0, int ld0,
                                          bf16_t* H1, const float* g1, const float* sh1, const float* sc1, int ld1,
                                          float* rstd_out) {
    const int rbase = blockIdx.x * 66;
    int cur_s = -1;
    f32x4 cg[8], a0[8], b0[8];
    for (int rr = wave; rr < 66; rr += 8) {
        const int r = rbase + rr; if (r >= M) break;
        const int s = seq_of_row(r);
        if (s != cur_s) { cur_s = s;
#pragma unroll
            for (int j = 0; j < 8; ++j) { const int c = 4 * lane + 256 * j;
                cg[j] = *(const f32x4*)(gate + (size_t)s * gld + c) * *(const f32x4*)(gpost + c);
                if (NOUT >= 1) { a0[j] = *(const f32x4*)(g0 + c) * (*(const f32x4*)(sc0 + (size_t)s * ld0 + c) + 1.0f); b0[j] = *(const f32x4*)(sh0 + (size_t)s * ld0 + c); } }
        }
        const float* xr = (r < MP) ? xp + (size_t)r * D : xs + (size_t)(r - MP) * D;
        const bf16_t* yr = Y + (size_t)r * D;
        f32x4 x[8]; u32x2 yw[8];
#pragma unroll
        for (int j = 0; j < 8; ++j) { x[j] = *(const f32x4*)(xr + 4 * lane + 256 * j); yw[j] = *(const u32x2*)(yr + 4 * lane + 256 * j); }
        float ss = 0.f;
#pragma unroll
        for (int j = 0; j < 8; ++j) { const f32x4 y = (f32x4){bf_lo(yw[j].x), bf_hi(yw[j].x), bf_lo(yw[j].y), bf_hi(yw[j].y)}; ss += (y[0] * y[0] + y[1] * y[1]) + (y[2] * y[2] + y[3] * y[3]); }
        const float ry = rsqrtf(wave_sum(ss) * (1.0f / D) + EPS);
        float sx = 0.f;
#pragma unroll
        for (int j = 0; j < 8; ++j) { const f32x4 y = (f32x4){bf_lo(yw[j].x), bf_hi(yw[j].x), bf_lo(yw[j].y), bf_hi(yw[j].y)}; x[j] = x[j] + cg[j] * (y * ry); sx += (x[j][0] * x[j][0] + x[j][1] * x[j][1]) + (x[j][2] * x[j][2] + x[j][3] * x[j][3]);
            *(f32x4*)(X + (size_t)r * D + 4 * lane + 256 * j) = x[j]; }
        if (NOUT >= 1 || rstd_out) {
            const float rx = rsqrtf(wave_sum(sx) * (1.0f / D) + EPS);
            if (rstd_out && lane == 0) rstd_out[r] = rx;
            if (NOUT >= 1) {
#pragma unroll
                for (int j = 0; j < 8; ++j) { const f32x4 h = x[j] * rx * a0[j] + b0[j]; u32x2 w; w.x = cvt_pk_bf16(h[0], h[1]); w.y = cvt_pk_bf16(h[2], h[3]);
                    *(u32x2*)(H0 + (size_t)r * D + 4 * lane + 256 * j) = w; }
            }
            if (NOUT >= 2) {
#pragma unroll
                for (int j = 0; j < 8; ++j) { const int c = 4 * lane + 256 * j;
                    const f32x4 a1 = *(const f32x4*)(g1 + c) * (*(const f32x4*)(sc1 + (size_t)s * ld1 + c) + 1.0f), b1 = *(const f32x4*)(sh1 + (size_t)s * ld1 + c);
                    const f32x4 h = x[j] * rx * a1 + b1; u32x2 w; w.x = cvt_pk_bf16(h[0], h[1]); w.y = cvt_pk_bf16(h[2], h[3]);
                    *(u32x2*)(H1 + (size_t)r * D + 4 * lane + 256 * j) = w; }
            }
        }
    }
}

__device__ __forceinline__ void attn_wave(const bf16_t* Qp  , bf16_t* Op, const bf16_t* Kb, const bf16_t* VT, int vstr, int npairs, int kfirst, int kstep_pair, bool sample, float sink2, int lane) {
    const int li = lane & 15, g = lane >> 4;
    bf16x8 qf[2][2];
#pragma unroll
    for (int qb = 0; qb < 2; ++qb)
#pragma unroll
        for (int ks = 0; ks < 2; ++ks) qf[qb][ks] = *(const bf16x8*)(Qp + (size_t)(16 * qb + li) * D + 32 * ks + 8 * g);
    f32x4 st[6][2][2];
#pragma unroll
    for (int p = 0; p < 6; ++p) {
        if (p < npairs) {
            const int k0 = sample ? (p == 0 ? 128 : 32 * (p - 1)) : kfirst - p * 32;
#pragma unroll
            for (int kh = 0; kh < 2; ++kh) {
                const bf16_t* kr = Kb + (size_t)(k0 + 16 * kh + li) * KVW + 8 * g;
                const bf16x8 kf0 = *(const bf16x8*)kr, kf1 = *(const bf16x8*)(kr + 32);
#pragma unroll
                for (int qb = 0; qb < 2; ++qb) {
                    f32x4 c = (f32x4){0.f, 0.f, 0.f, 0.f};
                    c = __builtin_amdgcn_mfma_f32_16x16x32_bf16(kf0, qf[qb][0], c, 0, 0, 0);
                    c = __builtin_amdgcn_mfma_f32_16x16x32_bf16(kf1, qf[qb][1], c, 0, 0, 0);
                    st[p][kh][qb] = c;
                }
            }
        }
    }
    (void)kstep_pair;
    float mx[2] = {sink2, sink2};
#pragma unroll
    for (int p = 0; p < 6; ++p) if (p < npairs) {
#pragma unroll
        for (int kh = 0; kh < 2; ++kh)
#pragma unroll
            for (int qb = 0; qb < 2; ++qb) { const f32x4 c = st[p][kh][qb]; mx[qb] = fmaxf(mx[qb], fmaxf(fmaxf(c[0], c[1]), fmaxf(c[2], c[3]))); }
    }
#pragma unroll
    for (int qb = 0; qb < 2; ++qb) { mx[qb] = fmaxf(mx[qb], __shfl_xor(mx[qb], 16)); mx[qb] = fmaxf(mx[qb], __shfl_xor(mx[qb], 32)); }
    float ls[2] = {0.f, 0.f};
    f32x4 o[4][2];
#pragma unroll
    for (int db = 0; db < 4; ++db)
#pragma unroll
        for (int qb = 0; qb < 2; ++qb) o[db][qb] = (f32x4){0.f, 0.f, 0.f, 0.f};
#pragma unroll
    for (int p = 0; p < 6; ++p) if (p < npairs) {
        const int k0 = sample ? (p == 0 ? 128 : 32 * (p - 1)) : kfirst - p * 32;
        bf16x8 pb[2];
#pragma unroll
        for (int qb = 0; qb < 2; ++qb) {
            float e[8];
#pragma unroll
            for (int j = 0; j < 4; ++j) { e[j] = __builtin_amdgcn_exp2f(st[p][0][qb][j] - mx[qb]); e[4 + j] = __builtin_amdgcn_exp2f(st[p][1][qb][j] - mx[qb]); }
            ls[qb] += ((e[0] + e[1]) + (e[2] + e[3])) + ((e[4] + e[5]) + (e[6] + e[7]));
            u32x4 w; w.x = cvt_pk_bf16(e[0], e[1]); w.y = cvt_pk_bf16(e[2], e[3]); w.z = cvt_pk_bf16(e[4], e[5]); w.w = cvt_pk_bf16(e[6], e[7]);
            pb[qb] = __builtin_bit_cast(bf16x8, w);
        }
#pragma unroll
        for (int db = 0; db < 4; ++db) {
            const bf16_t* vr = VT + (size_t)(16 * db + li) * vstr + k0 + 4 * g;
            const u32x2 v0 = *(const u32x2*)vr, v1 = *(const u32x2*)(vr + 16);
            const u32x4 vw = (u32x4){v0.x, v0.y, v1.x, v1.y};
            const bf16x8 vf = __builtin_bit_cast(bf16x8, vw);
#pragma unroll
            for (int qb = 0; qb < 2; ++qb) o[db][qb] = __builtin_amdgcn_mfma_f32_16x16x32_bf16(vf, pb[qb], o[db][qb], 0, 0, 0);
        }
    }
#pragma unroll
    for (int qb = 0; qb < 2; ++qb) {
        float l = ls[qb]; l += __shfl_xor(l, 16); l += __shfl_xor(l, 32);
        const float inv = 1.0f / (l + __builtin_amdgcn_exp2f(sink2 - mx[qb]));
#pragma unroll
        for (int db = 0; db < 4; ++db) { const f32x4 v = o[db][qb] * inv; u32x2 w; w.x = cvt_pk_bf16(v[0], v[1]); w.y = cvt_pk_bf16(v[2], v[3]);
            *(u32x2*)(Op + (size_t)(16 * qb + li) * D + 16 * db + 4 * g) = w; }
    }
}

__global__ void __launch_bounds__(NWAVES * 64, 2) mk_fwd(Args args) {
    extern __shared__ __attribute__((aligned(16))) unsigned char lds_raw[];
    LAS unsigned char* lds = (LAS unsigned char*)lds_raw;
    volatile LAS unsigned* MISC = (volatile LAS unsigned*)(lds + MISC_OFF);
    const int G = gridDim.x, bx = blockIdx.x;
    const int wave_s = __builtin_amdgcn_readfirstlane(threadIdx.x >> 6);
#define PH_IDS() const int tid = fresh_tid(wave_s), lane = tid & 63, wave = __builtin_amdgcn_readfirstlane(tid >> 6); (void)lane; (void)wave
    typedef const __attribute__((address_space(4))) Args* KArgs;
#define KA() ({ KArgs _p = (KArgs)__builtin_amdgcn_kernarg_segment_ptr(); asm volatile("" : "+s"(_p)); _p; })
#define IN(k) (KA()->in[k])
#define x_prompt IN(0)
#define x_sample IN(1)
#define c_prompt IN(2)
#define c_sample IN(3)
#define state_pool IN(4)
#define cache_k IN(5)
#define cache_v IN(6)
#define w_mod IN(7)
#define b_mod IN(8)
#define g_norm IN(9)
#define w_pool IN(10)
#define pool_scale IN(11)
#define w_kv_mod IN(12)
#define b_kv_mod IN(13)
#define g_kv IN(14)
#define w_kv IN(15)
#define w_q IN(16)
#define sinks IN(17)
#define w_o IN(18)
#define w_up IN(19)
#define w_down IN(20)
#define WSB() (KA()->ws)
#define out (KA()->out)
#define MOD ((float*)(WSB() + WS_MOD))
#define KVMOD ((float*)(WSB() + WS_KVMOD))
#define ROPE ((float*)(WSB() + WS_ROPE))
#define RSTD ((float*)(WSB() + WS_RSTD))
#define KS ((bf16_t*)(WSB() + WS_KS))
#define VTS ((bf16_t*)(WSB() + WS_VTS))
#define KP ((bf16_t*)(WSB() + WS_KP))
#define VTP ((bf16_t*)(WSB() + WS_VTP))
#define WPOOL ((bf16_t*)(WSB() + WS_WPOOL))
#define WKV ((bf16_t*)(WSB() + WS_WKV))
#define WQ ((bf16_t*)(WSB() + WS_WQ))
#define WO ((bf16_t*)(WSB() + WS_WO))
#define WUP ((bf16_t*)(WSB() + WS_WUP))
#define WDN ((bf16_t*)(WSB() + WS_WDN))
#define HB ((bf16_t*)(WSB() + WS_H))
#define QB ((bf16_t*)(WSB() + WS_Q))
#define YB ((bf16_t*)(WSB() + WS_Y))
#define HKVB ((bf16_t*)(WSB() + WS_HKV))
#define UB ((bf16_t*)(WSB() + WS_U))
#define X (out + O_Y)

    for (int u = threadIdx.x; u < (LDS_BYTES - LDSCTL_OFF) / 4; u += NWAVES * 64) ((LAS unsigned*)(lds + LDSCTL_OFF))[u] = 0u;
    __syncthreads();
#if !MK_MULTI
    XcdBarrier bar = xcd_barrier_post((unsigned*)(WSB() + WS_CTL) + CW_BAR, MISC + 8);
#define GRID_BAR() xcd_barrier(bar)
#else
#define GRID_BAR() do {} while (0)
#endif
    const int lo = KA()->ph_lo, hi = KA()->ph_hi;
    int ph = 0;
#ifndef MK_MASK
#define MK_MASK 0xffff
#endif
#define PHASE_ON() (lo <= ph && ph < hi)
#define PHASE_END() do { if (ph + 1 < hi && ph >= lo) GRID_BAR(); ++ph; } while (0)

    if (((MK_MASK >> 0) & 1) && PHASE_ON()) {
        PH_IDS();
        {
            LAS float* scl = (LAS float*)lds;
            LAS f32x4* red = (LAS f32x4*)lds;
            for (int cb = bx; cb < 208; cb += G) {
                const float* Wm; int ldw; const float* bias; float* outp; int ldo;
                if (cb < 192) { const int l = cb / 48, cbl = cb % 48; Wm = w_mod + (size_t)l * D * MODW + cbl * 256; ldw = MODW; bias = b_mod + l * MODW + cbl * 256; outp = MOD + (size_t)l * NSEQ * MODW + cbl * 256; ldo = MODW; }
                else { const int cbl = cb - 192; Wm = w_kv_mod + cbl * 256; ldw = 2 * D; bias = b_kv_mod + cbl * 256; outp = KVMOD + cbl * 256; ldo = 2 * D; }
                f32x4 acc[NSEQ];
#pragma unroll
                for (int s = 0; s < NSEQ; ++s) acc[s] = (f32x4){0.f, 0.f, 0.f, 0.f};
                for (int pass = 0; pass < 2; ++pass) {
                    __syncthreads();
                    for (int idx = tid; idx < NSEQ * 1024; idx += NWAVES * 64) { const int s = idx >> 10, k = idx & 1023, kk = 1024 * pass + k;
                        const float cv = (s < NBP) ? c_prompt[s * D + kk] : c_sample[(s - NBP) * D + kk];
                        scl[k * NSEQ + s] = cv / (1.0f + expf(-cv)); }
                    __syncthreads();
                    const float* wp = Wm + (size_t)(1024 * pass + wave * 128) * ldw + 4 * lane;
                    const LAS float* sp = scl + wave * 128 * NSEQ;
#pragma unroll 4
                    for (int k = 0; k < 128; ++k) {
                        const f32x4 wv = *(const f32x4*)(wp + (size_t)k * ldw);
                        const LAS f32x4* s4 = (const LAS f32x4*)(sp + k * NSEQ);
#pragma unroll
                        for (int q = 0; q < 5; ++q) { const f32x4 sv = s4[q]; acc[4 * q + 0] += wv * sv[0]; acc[4 * q + 1] += wv * sv[1]; acc[4 * q + 2] += wv * sv[2]; acc[4 * q + 3] += wv * sv[3]; }
                    }
                }
#pragma unroll
                for (int half = 0; half < 2; ++half) {
                    __syncthreads();
#pragma unroll
                    for (int s = 0; s < 10; ++s) red[(wave * 10 + s) * 64 + lane] = acc[half * 10 + s];
                    __syncthreads();
                    for (int o = tid; o < 640; o += NWAVES * 64) { const int s = o >> 6, ln = o & 63;
                        f32x4 sum = *(const f32x4*)(bias + 4 * ln);
#pragma unroll
                        for (int w = 0; w < 8; ++w) sum += red[(w * 10 + s) * 64 + ln];
                        *(f32x4*)(outp + (size_t)(half * 10 + s) * ldo + 4 * ln) = sum; }
                }
                __syncthreads();
            }
        }
        __syncthreads();
        {
            LAS float* scr = (LAS float*)(lds + wave * 16384);
            const int gw = bx * NWAVES + wave, NGW = G * NWAVES;
            constexpr int I_UP = (D / 64) * (FF / 32), I_DN = (FF / 64) * (D / 32), I_Q = (D / 64) * (D / 32), I_KV = (D / 64) * (512 / 32), I_PL = (512 / 64) * (512 / 32);
            constexpr int N_UP = 4 * I_UP, N_DN = 4 * I_DN, N_Q = 2 * I_Q, N_O = 2 * I_Q, N_KV = I_KV, N_PL = 8 * I_PL;
            constexpr int NITEMS = N_UP + N_DN + N_Q + N_O + N_KV + N_PL;
            for (int it = gw; it < NITEMS; it += NGW) {
                int r = it;
                if (r < N_UP) { const int l = r / I_UP; p0_transpose_item<false>(w_up + (size_t)l * D * FF, D, FF, WUP + (size_t)l * FF * D, scr, r % I_UP, lane); continue; } r -= N_UP;
                if (r < N_DN) { const int l = r / I_DN; p0_transpose_item<false>(w_down + (size_t)l * FF * D, FF, D, WDN + (size_t)l * D * FF, scr, r % I_DN, lane); continue; } r -= N_DN;
                if (r < N_Q) { const int j = r / I_Q; p0_transpose_item<true>(w_q + (size_t)j * D * D, D, D, WQ + (size_t)j * D * D, scr, r % I_Q, lane); continue; } r -= N_Q;
                if (r < N_O) { const int j = r / I_Q; p0_transpose_item<false>(w_o + (size_t)j * D * D, D, D, WO + (size_t)j * D * D, scr, r % I_Q, lane); continue; } r -= N_O;
                if (r < N_KV) { const int nb = r % 16;
                    if (nb < 8) p0_transpose_item<true>(w_kv, D, 512, WKV, scr, r, lane); else p0_transpose_item<false>(w_kv, D, 512, WKV, scr, r, lane); continue; } r -= N_KV;
                { const int lg = r / I_PL; p0_transpose_item<false>(w_pool + (size_t)lg * 512 * 512, 512, 512, WPOOL + (size_t)lg * 512 * 512, scr, r % I_PL, lane); }
            }
            for (int r = gw; r < M; r += NGW) {
                const float* xr = (r < MP) ? x_prompt + (size_t)r * D : x_sample + (size_t)(r - MP) * D;
                float ss = 0.f;
#pragma unroll
                for (int j = 0; j < 8; ++j) { const f32x4 v = *(const f32x4*)(xr + 4 * lane + 256 * j); ss += (v[0] * v[0] + v[1] * v[1]) + (v[2] * v[2] + v[3] * v[3]); }
                ss = wave_sum(ss);
                if (lane == 0) RSTD[r] = rsqrtf(ss * (1.0f / D) + EPS);
            }
            const int gt = bx * (NWAVES * 64) + tid, NGT = G * NWAVES * 64;
            for (int idx = gt; idx < NPOS * 32; idx += NGT) {
                const int pos = idx >> 5, i = idx & 31;
                double inv = 1.0; for (int q = 0; q < i; ++q) inv *= 0.74989420933245582730;
                const float ang = (float)pos * (float)inv;
                const double a = (double)ang;
                const double kq = __builtin_rint(a * 0.15915494309189533577);
                double rr = a - kq * 6.28318530717958623200; rr = rr - kq * 2.4492935982947064e-16;
                const double r2 = rr * rr;
                double sn = 0.0, cs = 0.0;
#pragma unroll
                for (int n = 14; n >= 0; --n) { sn = sn * (-r2) / (double)((2 * n + 2) * (2 * n + 3)) + 1.0; cs = cs * (-r2) / (double)((2 * n + 1) * (2 * n + 2)) + 1.0; }
                sn *= rr;
                ROPE[2 * idx] = (float)cs; ROPE[2 * idx + 1] = (float)sn;
            }
            for (int idx = gt; idx < NBS * 128 * KVW; idx += NGT) {
                const int sb = idx / (128 * KVW), rem = idx % (128 * KVW), key = rem / KVW, col = rem % KVW;
                const unsigned kw = cvt_pk_bf16(cache_k[idx], 0.f);
                KS[((size_t)sb * SKEYS + key) * KVW + col] = (bf16_t)(kw & 0xffff);
                const unsigned vw = cvt_pk_bf16(cache_v[idx], 0.f);
                VTS[((size_t)sb * KVW + col) * SKEYS + key] = (bf16_t)(vw & 0xffff);
            }
        }
    }
    PHASE_END();

    for (int l = 0; l < DEPTH; ++l) {
#define modl (MOD + (size_t)l * NSEQ * MODW)
#define gn (g_norm + (size_t)l * 4 * D)
        if (l < NA) {
            if (((MK_MASK >> 1) & 1) && PHASE_ON()) {
                PH_IDS();
                const int c = 4 * tid;
                const f32x4 gv = *(const f32x4*)(gn + c);
                for (int it = bx; it < 256 + NBS; it += G) {
                    const bool sample = it >= 256;
                    int s, t0, tend, pool_t0; const float* xsrc; const float* rs; bf16_t* P; const float* prefix = nullptr; float* pout;
                    if (!sample) { const int b = it >> 6; s = b; t0 = (it & 63) * 64; tend = t0 + 64; pool_t0 = SEQ - 15;
                        xsrc = (l == 0 ? x_prompt : X) + (size_t)b * SEQ * D; rs = RSTD + b * SEQ; P = HB + (size_t)b * SEQ * D; pout = out + O_PP + ((size_t)(l * NBP + b) * 15) * D; }
                    else { const int sb = it - 256; s = NBP + sb; t0 = 0; tend = DSEQ; pool_t0 = DSEQ - 15;
                        xsrc = (l == 0 ? x_sample : X + (size_t)MP * D) + (size_t)sb * DSEQ * D; rs = RSTD + MP + sb * DSEQ; P = HB + (size_t)(MP + sb * DSEQ) * D;
                        prefix = state_pool + ((size_t)(l * NBS + sb) * 15) * D; pout = out + O_PS + ((size_t)(l * NBS + sb) * 15) * D; }
                    const float* ms = modl + (size_t)s * MODW;
                    const f32x4 a = gv * (*(const f32x4*)(ms + 1 * D + c) + 1.0f), b = *(const f32x4*)(ms + 0 * D + c);
                    switch (wave >> 1) {
                        case 0: pool_item<2>(xsrc, rs, P, t0, tend, sample, prefix, pout, pool_t0, a, b, c); break;
                        case 1: pool_item<4>(xsrc, rs, P, t0, tend, sample, prefix, pout, pool_t0, a, b, c); break;
                        case 2: pool_item<8>(xsrc, rs, P, t0, tend, sample, prefix, pout, pool_t0, a, b, c); break;
                        default: pool_item<16>(xsrc, rs, P, t0, tend, sample, prefix, pout, pool_t0, a, b, c); break;
                    }
                }
            }
            PHASE_END();
            if (((MK_MASK >> 2) & 1) && PHASE_ON()) {
                pg8::SchedPool S{(const char*)HB, (const char*)(WPOOL + (size_t)l * D * 512), M / 256, G, bx};
                pg8::EpiBf16<2> E{YB, D, pool_scale + (size_t)l * D};
                pg8::gemm_phase(lds, wave_s, D, 512, S, E);
            }
            PHASE_END();
        } else {
            const int j = l - NA;
            if (((MK_MASK >> 3) & 1) && PHASE_ON()) {
                pg8::SchedQKV S{(const char*)WSB(), j, M / 256, (j == 0) ? 10 : 8, G, bx};
                pg8::EpiQKV E{WSB(), out};
                pg8::gemm_phase(lds, wave_s, D, D, S, E);
            }
            PHASE_END();
            if (((MK_MASK >> 4) & 1) && PHASE_ON()) {
                PH_IDS();
                for (int it = bx; it < 1024 + 64; it += G) {
                    if (it < 1024) {
                        const int kh = it & 3, n = (it >> 2) & 63, b = it >> 8, h = kh * 8 + wave;
                        const float sink2 = sinks[j * NH + h] * LOG2E;
                        const bf16_t* Kb = KP + (size_t)b * SEQ * KVW + kh * HD; const bf16_t* VT = VTP + (size_t)(b * NKV + kh) * HD * SEQ;
                        const int npairs = 2 * (n < 2 ? n + 1 : 3), kfirst = n * 64 + 32;
#pragma unroll 1
                        for (int hf = 0; hf < 2; ++hf) {
                            const size_t row = (size_t)b * SEQ + n * 64 + hf * 32;
                            attn_wave(QB + row * D + h * HD, QB + row * D + h * HD, Kb, VT, SEQ, npairs, kfirst, 0, false, sink2, lane);
                        }
                    } else {
                        const int u = it - 1024, sb = u >> 2, kh = u & 3, h = kh * 8 + wave;
                        const float sink2 = sinks[j * NH + h] * LOG2E;
                        const bf16_t* Kb = KS + (size_t)sb * SKEYS * KVW + kh * HD; const bf16_t* VT = VTS + (size_t)(sb * NKV + kh) * HD * SKEYS;
                        const size_t row = (size_t)MP + sb * DSEQ;
                        attn_wave(QB + row * D + h * HD, QB + row * D + h * HD, Kb, VT, SKEYS, 5, 0, 0, true, sink2, lane);
                    }
                }
            }
            PHASE_END();
            if (((MK_MASK >> 5) & 1) && PHASE_ON()) {
                pg8::SchedMN S{(const char*)QB, (const char*)(WO + (size_t)j * D * D), D, D, M / 256, D / 256, D / 64, G, bx};
                pg8::EpiBf16<0> E{YB, D, nullptr};
                pg8::gemm_phase(lds, wave_s, D, D, S, E);
            }
            PHASE_END();
        }
        if (((MK_MASK >> 6) & 1) && PHASE_ON()) {
            PH_IDS();
            const float* xp = (l == 0) ? x_prompt : X; const float* xs = (l == 0) ? x_sample : X + (size_t)MP * D;
            row_phase<1>(wave, lane, YB, xp, xs, X, gn + 1 * D, modl + 2 * D, MODW, HB, gn + 2 * D, modl + 3 * D, modl + 4 * D, MODW, nullptr, nullptr, nullptr, nullptr, 0, nullptr);
        }
        PHASE_END();
        if (((MK_MASK >> 7) & 1) && PHASE_ON()) {
            pg8::SchedMN S{(const char*)HB, (const char*)(WUP + (size_t)l * FF * D), D, D, M / 256, FF / 256, D / 64, G, bx};
            pg8::EpiBf16<1> E{UB, FF, nullptr};
            pg8::gemm_phase(lds, wave_s, D, D, S, E);
        }
        PHASE_END();
        if (((MK_MASK >> 8) & 1) && PHASE_ON()) {
            pg8::SchedMN S{(const char*)UB, (const char*)(WDN + (size_t)l * D * FF), FF, FF, M / 256, D / 256, FF / 64, G, bx};
            pg8::EpiBf16<0> E{YB, D, nullptr};
            pg8::gemm_phase(lds, wave_s, FF, FF, S, E);
        }
        PHASE_END();
        if (((MK_MASK >> 9) & 1) && PHASE_ON()) {
            PH_IDS();
            const float* xp = X; const float* xs = X + (size_t)MP * D;
            if (l == 0) {
                row_phase<0>(wave, lane, YB, xp, xs, X, gn + 3 * D, modl + 5 * D, MODW, nullptr, nullptr, nullptr, nullptr, 0, nullptr, nullptr, nullptr, nullptr, 0, RSTD);
            } else if (l == 1) {
                const float* modn = MOD + (size_t)(l + 1) * NSEQ * MODW; const float* gnn = g_norm + (size_t)(l + 1) * 4 * D;
                row_phase<2>(wave, lane, YB, xp, xs, X, gn + 3 * D, modl + 5 * D, MODW, HB, gnn, modn + 0 * D, modn + 1 * D, MODW, HKVB, g_kv, KVMOD, KVMOD + D, 2 * D, nullptr);
            } else if (l == 2) {
                const float* modn = MOD + (size_t)(l + 1) * NSEQ * MODW; const float* gnn = g_norm + (size_t)(l + 1) * 4 * D;
                row_phase<1>(wave, lane, YB, xp, xs, X, gn + 3 * D, modl + 5 * D, MODW, HB, gnn, modn + 0 * D, modn + 1 * D, MODW, nullptr, nullptr, nullptr, nullptr, 0, nullptr);
            } else {
                row_phase<0>(wave, lane, YB, xp, xs, X, gn + 3 * D, modl + 5 * D, MODW, nullptr, nullptr, nullptr, nullptr, 0, nullptr, nullptr, nullptr, nullptr, 0, nullptr);
            }
        }
        PHASE_END();
    }
}

#undef PH_IDS
#undef KA
#undef IN
#undef x_prompt
#undef x_sample
#undef c_prompt
#undef c_sample
#undef state_pool
#undef cache_k
#undef cache_v
#undef w_mod
#undef b_mod
#undef g_norm
#undef w_pool
#undef pool_scale
#undef w_kv_mod
#undef b_kv_mod
#undef g_kv
#undef w_kv
#undef w_q
#undef sinks
#undef w_o
#undef w_up
#undef w_down
#undef WSB
#undef out
#undef MOD
#undef KVMOD
#undef ROPE
#undef RSTD
#undef KS
#undef VTS
#undef KP
#undef VTP
#undef WPOOL
#undef WKV
#undef WQ
#undef WO
#undef WUP
#undef WDN
#undef HB
#undef QB
#undef YB
#undef HKVB
#undef UB
#undef X
#undef modl
#undef gn
extern "C" void kernel_launch(void* const* d_in, const int* in_sizes, int n_in, void* d_out, int out_size, void* d_ws, size_t ws_size, hipStream_t stream) {
    static int grid = 0;
    if (grid == 0) {
        if (n_in != 21 || (size_t)out_size != O_END || ws_size < WS_END) { fprintf(stderr, "kernel_launch: unexpected shapes (n_in %d out %d ws %zu)\n", n_in, out_size, ws_size); grid = -1; return; }
        int dev = 0, cus = 0, per_cu = 0;
        if (hipGetDevice(&dev) != hipSuccess || hipDeviceGetAttribute(&cus, hipDeviceAttributeMultiprocessorCount, dev) != hipSuccess) { grid = -1; return; }
        if (hipFuncSetAttribute((const void*)mk_fwd, hipFuncAttributeMaxDynamicSharedMemorySize, LDS_BYTES) != hipSuccess) { fprintf(stderr, "kernel_launch: hipFuncSetAttribute failed\n"); grid = -1; return; }
        if (hipOccupancyMaxActiveBlocksPerMultiprocessor(&per_cu, (const void*)mk_fwd, NWAVES * 64, LDS_BYTES) != hipSuccess || per_cu < 1)
            fprintf(stderr, "kernel_launch: occupancy query reports %d workgroups per CU\n", per_cu);
        (void)hipGetLastError();
        grid = cus;
    }
    if (grid < 0) return;
    (void)in_sizes;
    if (hipMemsetAsync((char*)d_ws + WS_CTL, 0, CTL_ZERO_BYTES, stream) != hipSuccess) return;
    Args a{};
    for (int i = 0; i < 21; ++i) a.in[i] = (const float*)d_in[i];
    a.out = (float*)d_out; a.ws = (unsigned char*)d_ws;
    const int nph = 1 + 2 * 6 + 2 * 7;
#if MK_MULTI
    for (int p = 0; p < nph; ++p) { a.ph_lo = p; a.ph_hi = p + 1; hipLaunchKernelGGL(mk_fwd, dim3(grid), dim3(NWAVES * 64), LDS_BYTES, stream, a); }
#else
    a.ph_lo = 0; a.ph_hi = nph;
    hipLaunchKernelGGL(mk_fwd, dim3(grid), dim3(NWAVES * 64), LDS_BYTES, stream, a);
#endif
    const hipError_t le = hipPeekAtLastError();
    if (le != hipSuccess) fprintf(stderr, "kernel_launch: launch failed: %s\n", hipGetErrorName(le));
}
```

```cpp
#include <hip/hip_runtime.h>
#include <cstdio>
#include <cstdint>

#ifndef MK_MULTI
#define MK_MULTI 0
#endif

constexpr int D = 2048, FF = 8192, NSEQ = 20, MP = 16384, MS = 512, M = MP + MS, SEQ = 4096, DSEQ = 32, NBP = 4, NBS = 16;
constexpr int DEPTH = 4, NA = 2, HD = 64, NH = 32, NKV = 4, KVW = NKV * HD  , SKEYS = 160  ;
constexpr int MODW = 6 * D;
constexpr float EPS = 1e-6f;
constexpr float QSCALE = 0.125f * 1.4426950408889634f;
constexpr float LOG2E = 1.4426950408889634f;
constexpr int NPOS = SEQ + DSEQ;

constexpr size_t O_Y = 0, O_PP = (size_t)M * D, O_PS = O_PP + (size_t)NA * NBP * 15 * D, O_KP = O_PS + (size_t)NA * NBS * 15 * D,
                 O_VP = O_KP + (size_t)NBP * 128 * KVW, O_KS = O_VP + (size_t)NBP * 128 * KVW, O_VS = O_KS + (size_t)NBS * DSEQ * KVW, O_END = O_VS + (size_t)NBS * DSEQ * KVW;

constexpr size_t MiB = 1u << 20;
constexpr size_t WS_CTL = 0, CTL_ZERO_BYTES = 1 * MiB;
constexpr size_t WS_MOD = 2 * MiB;
constexpr size_t WS_KVMOD = WS_MOD + (size_t)DEPTH * NSEQ * MODW * 4;
constexpr size_t WS_ROPE = 7 * MiB;
constexpr size_t WS_RSTD = 9 * MiB;
constexpr size_t WS_KS = 10 * MiB;
constexpr size_t WS_VTS = 12 * MiB;
constexpr size_t WS_KP = 16 * MiB;
constexpr size_t WS_VTP = 24 * MiB;
constexpr size_t WS_WPOOL = 32 * MiB;
constexpr size_t WS_WKV = 36 * MiB;
constexpr size_t WS_WQ = 40 * MiB;
constexpr size_t WS_WO = 56 * MiB;
constexpr size_t WS_WUP = 72 * MiB;
constexpr size_t WS_WDN = 200 * MiB;
constexpr size_t WS_H = 328 * MiB;
constexpr size_t WS_Q = 394 * MiB;
constexpr size_t WS_Y = 460 * MiB;
constexpr size_t WS_HKV = 526 * MiB;
constexpr size_t WS_U = 592 * MiB;
constexpr size_t WS_SLAB = 856 * MiB;
constexpr size_t WS_END = 920 * MiB;
static_assert(WS_KVMOD + (size_t)NSEQ * 4096 * 4 <= WS_ROPE, "ws map");
static_assert(WS_ROPE + (size_t)NPOS * 32 * 8 <= WS_RSTD, "ws map");

constexpr int CW_BAR = 4096;

constexpr int RING_BYTES = 131072, LDSCTL_OFF = RING_BYTES, MISC_OFF = LDSCTL_OFF + 320, LDS_BYTES = 147456;
constexpr int NWAVES = 8;

#define GAS __attribute__((address_space(1)))
#define LAS __attribute__((address_space(3)))
typedef unsigned short bf16_t;
typedef short bf16x8 __attribute__((ext_vector_type(8)));
typedef float f32x4 __attribute__((ext_vector_type(4)));
typedef float f32x2 __attribute__((ext_vector_type(2)));
typedef unsigned u32x4 __attribute__((ext_vector_type(4)));
typedef unsigned u32x2 __attribute__((ext_vector_type(2)));

__device__ __forceinline__ unsigned cvt_pk_bf16(float lo, float hi) { unsigned r; asm volatile("v_cvt_pk_bf16_f32 %0, %1, %2" : "=v"(r) : "v"(lo), "v"(hi)); return r; }
__device__ __forceinline__ float bf_lo(unsigned w) { return __uint_as_float(w << 16); }
__device__ __forceinline__ float bf_hi(unsigned w) { return __uint_as_float(w & 0xffff0000u); }
__device__ __forceinline__ int fresh_tid(int wave_s) { unsigned z = (unsigned)wave_s * 64u; asm volatile("" : "+s"(z)); return (int)__builtin_amdgcn_mbcnt_hi(~0u, __builtin_amdgcn_mbcnt_lo(~0u, z)); }
__device__ __forceinline__ float wave_sum(float v) {
#pragma unroll
    for (int o = 1; o < 64; o <<= 1) v += __shfl_xor(v, o);
    return v;
}

namespace pg8 {
constexpr int BM = 256, BK = 64, HALF = 128, HTB = HALF * BK * 2, STAGE_BYTES = 8 * HTB, NXCD = 8, WGM = 8;
__host__ __device__ __forceinline__ int lds_byte(int r, int c) { const int st = (r >> 4) * 2 + (c >> 5), rr = r & 15, cc = c & 31, ob = rr * 64 + cc * 2; return st * 1024 + (ob ^ (((ob >> 9) & 1) << 5)); }
__host__ __device__ __forceinline__ void stage_rc(int b, int& R, int& C) { const int st = b / 1024, sb = b % 1024, swz = sb ^ (((sb >> 9) & 1) << 5); R = (st >> 1) * 16 + swz / 64; C = (st & 1) * 32 + (swz % 64) / 2; }
__host__ __device__ __forceinline__ int perm32(int rho) { const int n = rho >> 4, i = rho & 15; return 8 * (i >> 2) + 4 * n + (i & 3); }

struct Unit { const char* pa; const char* pb; int nt, pm, pn, kind; };

__device__ __forceinline__ bool tile_of(int i, int G, int c, int nM, int nN, int& pm, int& pn) {
    const int nwg = nM * nN; const long L = (long)i * G + c; if (L >= nwg) return false;
    int wgid = (int)L; { const int q = nwg / NXCD, r = nwg % NXCD, xcd = wgid % NXCD, off = wgid / NXCD; wgid = (xcd < r ? xcd * (q + 1) : r * (q + 1) + (xcd - r) * q) + off; }
    const int nig = WGM * nN, gid = wgid / nig, fm = gid * WGM, gsz = (nM - fm) < WGM ? (nM - fm) : WGM;
    pm = fm + ((wgid % nig) % gsz); pn = (wgid % nig) / gsz; return true;
}

template <class Epi, class Sched>
__device__ __forceinline__ void gemm_phase(LAS unsigned char* lds, const int wave_s, const int lda, const int ldb, const Sched& S, const Epi& E) {
    const int tid = fresh_tid(wave_s), wid = __builtin_amdgcn_readfirstlane(tid >> 6), lane = tid & 63, wr = wid >> 2, wc = wid & 3, fr = lane & 15, fq = lane >> 4;
    unsigned voffA[2], voffB[2];
#pragma unroll
    for (int i = 0; i < 2; ++i) { int R, C; stage_rc(tid * 16 + i * 8192, R, C); const int Rb = (R & ~31) + perm32(R & 31);
        voffA[i] = (unsigned)(R * lda + C) * 2u; voffB[i] = (unsigned)(Rb * ldb + C) * 2u; }
    const size_t kstep = (size_t)(BK * 2);
    const size_t hstepA = (size_t)HALF * lda * 2, hstepB = (size_t)HALF * ldb * 2;
    const unsigned ldsw = (unsigned)wid * 1024u;
    const int aoff = lds_byte(wr * 64 + fr, fq * 8), boff = lds_byte(wc * 32 + fr, fq * 8);
#define PG8_SA(b, h) (((b) * 2 + (h)) * HTB)
#define PG8_SB(b, h) ((4 + (b) * 2 + (h)) * HTB)
#define PG8_STAGE(bufoff, gbase, voff) do { _Pragma("unroll") for (int _i = 0; _i < 2; ++_i) \
        __builtin_amdgcn_global_load_lds((const unsigned*)((const char*)(gbase) + (voff)[_i]), (LAS unsigned*)(lds + (bufoff) + ldsw + _i * 8192), 16, 0, 0); } while (0)
#define PG8_LDA(dst, b, h) do { _Pragma("unroll") for (int m = 0; m < 4; ++m) _Pragma("unroll") for (int k = 0; k < 2; ++k) dst[m][k] = *(const LAS bf16x8*)(lds + PG8_SA(b, h) + aoff + m * 2048 + k * 1024); } while (0)
#define PG8_LDB(dst, b, h) do { _Pragma("unroll") for (int n = 0; n < 2; ++n) _Pragma("unroll") for (int k = 0; k < 2; ++k) dst[n][k] = *(const LAS bf16x8*)(lds + PG8_SB(b, h) + boff + n * 2048 + k * 1024); } while (0)
#define PG8_MMA(ai, bj, At, Bt) do { __builtin_amdgcn_s_setprio(1); _Pragma("unroll") for (int m = 0; m < 4; ++m) _Pragma("unroll") for (int n = 0; n < 2; ++n) _Pragma("unroll") for (int k = 0; k < 2; ++k) \
        acc[ai][bj][m][n] = __builtin_amdgcn_mfma_f32_16x16x32_bf16(Bt[n][k], At[m][k], acc[ai][bj][m][n], 0, 0, 0); __builtin_amdgcn_s_setprio(0); } while (0)
#define PG8_WAIT_V(n) asm volatile("s_waitcnt vmcnt(" #n ")" ::: "memory")
#define PG8_WAIT_L(n) asm volatile("s_waitcnt lgkmcnt(" #n ")" ::: "memory")
#define PG8_BAR __builtin_amdgcn_s_barrier()
#define PG8_SCHED __builtin_amdgcn_sched_barrier(0)
    Unit cur, nxt; int ui = 0;
    if (!S.next(0, cur)) return;
    f32x4 acc[2][2][4][2];
#pragma unroll
    for (int a = 0; a < 2; ++a)
#pragma unroll
        for (int b = 0; b < 2; ++b)
#pragma unroll
            for (int m = 0; m < 4; ++m)
#pragma unroll
                for (int n = 0; n < 2; ++n) acc[a][b][m][n] = (f32x4){0.f, 0.f, 0.f, 0.f};
    bf16x8 At[4][2], B0[2][2], B1[2][2];
    const char* cA = cur.pa; const char* cB = cur.pb;
    PG8_STAGE(PG8_SB(0, 0), cB, voffB); PG8_STAGE(PG8_SB(0, 1), cB + hstepB, voffB); PG8_STAGE(PG8_SA(0, 0), cA, voffA); PG8_STAGE(PG8_SA(0, 1), cA + hstepA, voffA);
    if (wr == 1) PG8_BAR;
    PG8_WAIT_V(2); PG8_BAR;
    PG8_STAGE(PG8_SB(1, 0), cB + kstep, voffB); PG8_STAGE(PG8_SA(1, 0), cA + kstep, voffA); PG8_STAGE(PG8_SB(1, 1), cB + hstepB + kstep, voffB);
    PG8_WAIT_V(6); PG8_BAR;
    for (;;) {
        const bool has_next = S.next(ui + 1, nxt);
        const char* nA = has_next ? nxt.pa : cA; const char* nB = has_next ? nxt.pb : cB;
        const int nt = cur.nt;
        for (int t = 0; t < nt; t += 2) {
            const bool last = (t == nt - 2);
            const char* a1 = cA + (size_t)(t + 1) * kstep;
            const char* a2 = last ? nA : cA + (size_t)(t + 2) * kstep; const char* b2 = last ? nB : cB + (size_t)(t + 2) * kstep;
            const char* a3 = a2 + kstep; const char* b3 = b2 + kstep;
            PG8_LDB(B0, 0, 0); PG8_LDB(B1, 0, 1); PG8_SCHED; PG8_LDA(At, 0, 0); PG8_STAGE(PG8_SA(1, 1), a1 + hstepA, voffA);
            PG8_WAIT_V(8); PG8_WAIT_L(0); PG8_BAR; PG8_MMA(0, 0, At, B0); PG8_MMA(0, 1, At, B1); PG8_BAR; PG8_SCHED;
            PG8_LDA(At, 0, 1); PG8_STAGE(PG8_SB(0, 0), b2, voffB); PG8_STAGE(PG8_SB(0, 1), b2 + hstepB, voffB); PG8_STAGE(PG8_SA(0, 0), a2, voffA);
            PG8_WAIT_V(8); PG8_WAIT_L(0); PG8_BAR; PG8_MMA(1, 0, At, B0); PG8_MMA(1, 1, At, B1); PG8_BAR; PG8_SCHED;
            PG8_LDB(B0, 1, 0); PG8_LDB(B1, 1, 1); PG8_SCHED; PG8_LDA(At, 1, 0); PG8_STAGE(PG8_SA(0, 1), a2 + hstepA, voffA);
            PG8_WAIT_V(8); PG8_WAIT_L(0); PG8_BAR; PG8_MMA(0, 0, At, B0); PG8_MMA(0, 1, At, B1); PG8_BAR; PG8_SCHED;
            PG8_LDA(At, 1, 1); PG8_STAGE(PG8_SB(1, 0), b3, voffB); PG8_STAGE(PG8_SB(1, 1), b3 + hstepB, voffB); PG8_STAGE(PG8_SA(1, 0), a3, voffA);
            PG8_WAIT_V(8); PG8_WAIT_L(0); PG8_BAR; PG8_MMA(1, 0, At, B0); PG8_MMA(1, 1, At, B1); PG8_BAR; PG8_SCHED;
        }
        if (wr == 0) PG8_BAR;
        E(acc, cur, wr, wc, fr, fq);
        if (!has_next) break;
#pragma unroll
        for (int a = 0; a < 2; ++a)
#pragma unroll
            for (int b = 0; b < 2; ++b)
#pragma unroll
                for (int m = 0; m < 4; ++m)
#pragma unroll
                    for (int n = 0; n < 2; ++n) acc[a][b][m][n] = (f32x4){0.f, 0.f, 0.f, 0.f};
        cur = nxt; cA = nA; cB = nB; ++ui;
        if (wr == 1) PG8_BAR;
    }
    PG8_WAIT_V(0);
    PG8_BAR;
#undef PG8_SA
#undef PG8_SB
#undef PG8_STAGE
#undef PG8_LDA
#undef PG8_LDB
#undef PG8_MMA
#undef PG8_WAIT_V
#undef PG8_WAIT_L
#undef PG8_BAR
#undef PG8_SCHED
}

struct SchedMN {
    const char* A; const char* Bt; int lda, ldb, nM, nN, nt, G, c;
    __device__ __forceinline__ bool next(int i, Unit& u) const {
        int pm, pn; if (!tile_of(i, G, c, nM, nN, pm, pn)) return false;
        u.pa = A + (size_t)pm * BM * lda * 2; u.pb = Bt + (size_t)pn * BM * ldb * 2; u.nt = nt; u.pm = pm; u.pn = pn; u.kind = 0; return true;
    }
};
struct SchedPool {
    const char* A; const char* Bt; int nM, G, c;
    __device__ __forceinline__ bool next(int i, Unit& u) const {
        int pm, pn; if (!tile_of(i, G, c, nM, 8, pm, pn)) return false;
        u.pa = A + ((size_t)pm * BM * D + (size_t)(pn >> 1) * 512) * 2; u.pb = Bt + (size_t)pn * BM * 512 * 2; u.nt = 8; u.pm = pm; u.pn = pn; u.kind = 0; return true;
    }
};
struct SchedSplit {
    const char* A; const char* Bt; int lda, ldb, nN, nt, NS, ntS, G, c; bool pool;
    __device__ __forceinline__ bool next(int i, Unit& u) const {
        int pm, pn;
        if (tile_of(i, G, c, MP / BM, nN, pm, pn)) {
            u.pa = A + ((size_t)pm * BM * lda + (pool ? (size_t)(pn >> 1) * 512 : 0)) * 2; u.pb = Bt + (size_t)pn * BM * ldb * 2; u.nt = nt; u.pm = pm; u.pn = pn; u.kind = 0; return true; }
        const long js = (long)i * G + c - (long)(MP / BM) * nN;
        if (js < 0 || js >= (long)2 * nN * NS) return false;
        const int ks = (int)js / (2 * nN), rem = (int)js % (2 * nN), pms = rem / nN; pn = rem % nN;
        const size_t koff = (size_t)ks * ntS * BK;
        u.pa = A + ((size_t)(MP + pms * BM) * lda + koff + (pool ? (size_t)(pn >> 1) * 512 : 0)) * 2; u.pb = Bt + ((size_t)pn * BM * ldb + koff) * 2;
        u.nt = ntS; u.pm = pms; u.pn = pn; u.kind = 1 + ks; return true;
    }
};
struct SchedQKV {
    const char* wsb; int j, nM, nN, G, c;
    __device__ __forceinline__ bool next(int i, Unit& u) const {
        int pm, pn; if (!tile_of(i, G, c, nM, nN, pm, pn)) return false;
        if (pn < 8) { u.pa = wsb + WS_H + (size_t)pm * BM * D * 2; u.pb = wsb + WS_WQ + ((size_t)j * D + (size_t)pn * BM) * D * 2; u.kind = 0; u.pn = pn; }
        else { u.pa = wsb + WS_HKV + (size_t)pm * BM * D * 2; u.pb = wsb + WS_WKV + (size_t)(pn - 8) * BM * D * 2; u.kind = pn - 7; u.pn = pn - 8; }
        u.nt = D / BK; u.pm = pm; return true;
    }
};

template <int ACT  > struct EpiBf16 {
    bf16_t* O; int ldc; const float* cs;
    __device__ __forceinline__ void operator()(const f32x4 (&acc)[2][2][4][2], const Unit& u, int wr, int wc, int fr, int fq) const {
        const int row0 = u.pm * BM + wr * 64 + fr, col0 = u.pn * BM + wc * 32 + 8 * fq;
        f32x4 sv[2][2];
        if (ACT == 2) {
#pragma unroll
            for (int bj = 0; bj < 2; ++bj)
#pragma unroll
                for (int n = 0; n < 2; ++n) sv[bj][n] = *(const f32x4*)(cs + col0 + bj * HALF + 4 * n);
        }
#pragma unroll
        for (int ai = 0; ai < 2; ++ai)
#pragma unroll
            for (int m = 0; m < 4; ++m) { bf16_t* rowp = O + (size_t)(row0 + ai * HALF + m * 16) * ldc + col0;
#pragma unroll
                for (int bj = 0; bj < 2; ++bj) { f32x4 v0 = acc[ai][bj][m][0], v1 = acc[ai][bj][m][1];
                    if (ACT == 1) {
#pragma unroll
                        for (int e = 0; e < 4; ++e) { const float a = fmaxf(v0[e], 0.f), b = fmaxf(v1[e], 0.f); v0[e] = a * a; v1[e] = b * b; } }
                    if (ACT == 2) { v0 = v0 * sv[bj][0]; v1 = v1 * sv[bj][1]; }
                    u32x4 w; w.x = cvt_pk_bf16(v0[0], v0[1]); w.y = cvt_pk_bf16(v0[2], v0[3]); w.z = cvt_pk_bf16(v1[0], v1[1]); w.w = cvt_pk_bf16(v1[2], v1[3]);
                    *(u32x4*)(rowp + bj * HALF) = w; } }
    }
};

template <int ACT  > struct EpiSplit {
    bf16_t* O; float* slab; const float* cs;
    __device__ __forceinline__ void operator()(const f32x4 (&acc)[2][2][4][2], const Unit& u, int wr, int wc, int fr, int fq) const {
        const int row0 = u.pm * BM + wr * 64 + fr, col0 = u.pn * BM + wc * 32 + 8 * fq;
#pragma unroll
        for (int bj = 0; bj < 2; ++bj) {
            f32x4 s0 = (f32x4){1.f, 1.f, 1.f, 1.f}, s1 = s0;
            if (ACT == 2) { s0 = *(const f32x4*)(cs + col0 + bj * HALF); s1 = *(const f32x4*)(cs + col0 + bj * HALF + 4); }
            if (u.kind == 0) {
#pragma unroll
                for (int ai = 0; ai < 2; ++ai)
#pragma unroll
                    for (int m = 0; m < 4; ++m) { bf16_t* rowp = O + (size_t)(row0 + ai * HALF + m * 16) * D + col0 + bj * HALF;
                        f32x4 v0 = acc[ai][bj][m][0], v1 = acc[ai][bj][m][1];
                        if (ACT == 2) { v0 = v0 * s0; v1 = v1 * s1; }
                        u32x4 w; w.x = cvt_pk_bf16(v0[0], v0[1]); w.y = cvt_pk_bf16(v0[2], v0[3]); w.z = cvt_pk_bf16(v1[0], v1[1]); w.w = cvt_pk_bf16(v1[2], v1[3]);
                        *(u32x4*)rowp = w; }
            } else {
                float* sl = slab + (size_t)(u.kind - 1) * MS * D;
#pragma unroll
                for (int ai = 0; ai < 2; ++ai)
#pragma unroll
                    for (int m = 0; m < 4; ++m) { float* rowp = sl + (size_t)(row0 + ai * HALF + m * 16) * D + col0 + bj * HALF;
                        f32x4 v0 = acc[ai][bj][m][0], v1 = acc[ai][bj][m][1];
                        if (ACT == 2) { v0 = v0 * s0; v1 = v1 * s1; }
                        *(f32x4*)rowp = v0; *(f32x4*)(rowp + 4) = v1; }
            }
        }
    }
};

struct EpiQKV {
    unsigned char* wsb; float* out;
    __device__ __forceinline__ void operator()(const f32x4 (&acc)[2][2][4][2], const Unit& u, int wr, int wc, int fr, int fq) const {
        bf16_t* const Q = (bf16_t*)(wsb + WS_Q); const float* const rope = (const float*)(wsb + WS_ROPE); bf16_t* const KP = (bf16_t*)(wsb + WS_KP); bf16_t* const KS = (bf16_t*)(wsb + WS_KS);
        bf16_t* const VTP = (bf16_t*)(wsb + WS_VTP); bf16_t* const VTS = (bf16_t*)(wsb + WS_VTS);
#pragma unroll
        for (int ai = 0; ai < 2; ++ai)
#pragma unroll
            for (int m = 0; m < 4; ++m) {
                const int r = u.pm * BM + ai * HALF + wr * 64 + m * 16 + fr;
                const bool prompt = r < MP;
                const int b = prompt ? (r >> 12) : ((r - MP) >> 5), t = prompt ? (r & 4095) : ((r - MP) & 31), pos = prompt ? t : SEQ + t;
                if (u.kind != 2) {
                    const f32x4* cp = (const f32x4*)(rope + ((size_t)pos * 32 + 8 * fq) * 2);
                    const f32x4 f0 = cp[0], f1 = cp[1], f2 = cp[2], f3 = cp[3];
                    const float cs_[8] = {f0[0], f0[2], f1[0], f1[2], f2[0], f2[2], f3[0], f3[2]};
                    const float sn_[8] = {f0[1], f0[3], f1[1], f1[3], f2[1], f2[3], f3[1], f3[3]};
                    float o1[8], o2[8];
#pragma unroll
                    for (int n = 0; n < 2; ++n)
#pragma unroll
                        for (int e = 0; e < 4; ++e) { const int k = 4 * n + e; const float x1 = acc[ai][0][m][n][e], x2 = acc[ai][1][m][n][e];
                            o1[k] = x1 * cs_[k] - x2 * sn_[k]; o2[k] = x2 * cs_[k] + x1 * sn_[k]; }
                    if (u.kind == 0) {
                        bf16_t* qp = Q + (size_t)r * D + u.pn * BM + wc * 64 + 8 * fq;
                        u32x4 w1, w2;
                        w1.x = cvt_pk_bf16(o1[0] * QSCALE, o1[1] * QSCALE); w1.y = cvt_pk_bf16(o1[2] * QSCALE, o1[3] * QSCALE); w1.z = cvt_pk_bf16(o1[4] * QSCALE, o1[5] * QSCALE); w1.w = cvt_pk_bf16(o1[6] * QSCALE, o1[7] * QSCALE);
                        w2.x = cvt_pk_bf16(o2[0] * QSCALE, o2[1] * QSCALE); w2.y = cvt_pk_bf16(o2[2] * QSCALE, o2[3] * QSCALE); w2.z = cvt_pk_bf16(o2[4] * QSCALE, o2[5] * QSCALE); w2.w = cvt_pk_bf16(o2[6] * QSCALE, o2[7] * QSCALE);
                        *(u32x4*)qp = w1; *(u32x4*)(qp + 32) = w2;
                    } else {
                        const int col = wc * 64 + 8 * fq;
                        bf16_t* kp = prompt ? KP + (size_t)r * KVW + col : KS + ((size_t)b * SKEYS + 128 + t) * KVW + col;
                        u32x4 w1, w2;
                        w1.x = cvt_pk_bf16(o1[0], o1[1]); w1.y = cvt_pk_bf16(o1[2], o1[3]); w1.z = cvt_pk_bf16(o1[4], o1[5]); w1.w = cvt_pk_bf16(o1[6], o1[7]);
                        w2.x = cvt_pk_bf16(o2[0], o2[1]); w2.y = cvt_pk_bf16(o2[2], o2[3]); w2.z = cvt_pk_bf16(o2[4], o2[5]); w2.w = cvt_pk_bf16(o2[6], o2[7]);
                        *(u32x4*)kp = w1; *(u32x4*)(kp + 32) = w2;
                        float* fo = nullptr;
                        if (prompt) { if (t >= SEQ - 128) fo = out + O_KP + ((size_t)b * 128 + (t - (SEQ - 128))) * KVW + col; }
                        else fo = out + O_KS + (size_t)(r - MP) * KVW + col;
                        if (fo) { *(f32x4*)fo = (f32x4){o1[0], o1[1], o1[2], o1[3]}; *(f32x4*)(fo + 4) = (f32x4){o1[4], o1[5], o1[6], o1[7]};
                                  *(f32x4*)(fo + 32) = (f32x4){o2[0], o2[1], o2[2], o2[3]}; *(f32x4*)(fo + 36) = (f32x4){o2[4], o2[5], o2[6], o2[7]}; }
                    }
                } else {
#pragma unroll
                    for (int bj = 0; bj < 2; ++bj) {
                        const int col = bj * HALF + wc * 32 + 8 * fq;
                        const int kh = col >> 6, d0 = col & 63;
                        bf16_t* vt = prompt ? VTP + ((size_t)(b * NKV + kh) * HD + d0) * SEQ + t : VTS + ((size_t)(b * NKV + kh) * HD + d0) * SKEYS + 128 + t;
                        const size_t vstr = prompt ? SEQ : SKEYS;
                        const f32x4 v0 = acc[ai][bj][m][0], v1 = acc[ai][bj][m][1];
                        const unsigned p0 = cvt_pk_bf16(v0[0], v0[1]), p1 = cvt_pk_bf16(v0[2], v0[3]), p2 = cvt_pk_bf16(v1[0], v1[1]), p3 = cvt_pk_bf16(v1[2], v1[3]);
                        vt[0 * vstr] = (bf16_t)(p0 & 0xffff); vt[1 * vstr] = (bf16_t)(p0 >> 16); vt[2 * vstr] = (bf16_t)(p1 & 0xffff); vt[3 * vstr] = (bf16_t)(p1 >> 16);
                        vt[4 * vstr] = (bf16_t)(p2 & 0xffff); vt[5 * vstr] = (bf16_t)(p2 >> 16); vt[6 * vstr] = (bf16_t)(p3 & 0xffff); vt[7 * vstr] = (bf16_t)(p3 >> 16);
                        float* fo = nullptr;
                        if (prompt) { if (t >= SEQ - 128) fo = out + O_VP + ((size_t)b * 128 + (t - (SEQ - 128))) * KVW + col; }
                        else fo = out + O_VS + (size_t)(r - MP) * KVW + col;
                        if (fo) { *(f32x4*)fo = v0; *(f32x4*)(fo + 4) = v1; }
                    }
                }
            }
    }
};
}

#define XB_TMO      128
#define XB_XCNT(j)  (256  + 64 * (j))
#define XB_XSUB(j)  (1280 + 64 * (j))
#define XB_XGEN(j)  (2304 + 64 * (j))
#define XB_TOP      3328
#define XB_TOPGEN   3392
#define XCD_BAR_WORDS 3456
#define XB_SPIN_CAP (1u << 18)

__device__ __forceinline__ unsigned xb_ld(unsigned* p)              { return __hip_atomic_load(p, __ATOMIC_RELAXED, __HIP_MEMORY_SCOPE_AGENT); }
__device__ __forceinline__ unsigned xb_add(unsigned* p, unsigned v) { return __hip_atomic_fetch_add(p, v, __ATOMIC_RELAXED, __HIP_MEMORY_SCOPE_AGENT); }
__device__ __forceinline__ unsigned xb_xcc_id() { return (unsigned)__builtin_amdgcn_s_getreg((3 << 11) | 20) & 0xFu; }
#define XB_SPIN(cond, bar) do { unsigned _sp = 0; while (cond) { __builtin_amdgcn_s_sleep(1); \
    if ((++_sp & 255u) == 0u) { if (xb_ld(&(bar)[XB_TMO])) break; if (_sp > XB_SPIN_CAP) { atomicAdd(&(bar)[XB_TMO], 1u); break; } } } } while (0)

struct XcdBarrier { unsigned* bar; unsigned x; volatile LAS unsigned* st; };

__device__ __forceinline__ XcdBarrier xcd_barrier_post(unsigned* bar, volatile LAS unsigned* st) {
    XcdBarrier b; b.bar = bar; b.x = xb_xcc_id(); b.st = st;
    if (threadIdx.x == 0) (void)xb_add(&bar[XB_XCNT(b.x)], 1u);
    return b;
}
__device__ __forceinline__ void xcd_barrier_complete(unsigned* bar, unsigned x, unsigned& nloc, unsigned& nx) {
    const unsigned G = gridDim.x * gridDim.y * gridDim.z;
    unsigned sum, cnt, mine, sp = 0u;
    for (;;) {
        sum = 0u; cnt = 0u; mine = 0u;
#pragma unroll
        for (unsigned j = 0; j < 16; ++j) { const unsigned c = xb_ld(&bar[XB_XCNT(j)]); sum += c; cnt += (c > 0u) ? 1u : 0u; mine = (j == x) ? c : mine; }
        if (sum == G) break;
        __builtin_amdgcn_s_sleep(1);
        if ((++sp & 255u) == 0u) { if (xb_ld(&bar[XB_TMO])) break; if (sp > XB_SPIN_CAP) { atomicAdd(&bar[XB_TMO], 1u); break; } }
    }
    nloc = mine > 0u ? mine : 1u; nx = cnt > 0u ? cnt : 1u;
}
__device__ __forceinline__ void xcd_barrier(const XcdBarrier& b) {
    asm volatile("s_waitcnt vmcnt(0)" ::: "memory");
    __syncthreads();
    if (threadIdx.x == 0) {
        unsigned* bar = b.bar;
        __builtin_amdgcn_s_waitcnt(0);
        unsigned nloc = b.st[0], nx = b.st[1];
        if (nloc == 0u) { xcd_barrier_complete(bar, b.x, nloc, nx); b.st[0] = nloc; b.st[1] = nx; }
        const unsigned old = xb_add(&bar[XB_XSUB(b.x)], 1u);
        const unsigned gen = old / nloc;
        if (old + 1u == (gen + 1u) * nloc) {
            __builtin_amdgcn_fence(__ATOMIC_RELEASE, "agent");
            asm volatile("s_waitcnt vmcnt(0)" ::: "memory");
            const unsigned og = xb_add(&bar[XB_TOP], 1u);
            const unsigned tg = og / nx;
            if (og + 1u == (tg + 1u) * nx) xb_add(&bar[XB_TOPGEN], 1u);
            else XB_SPIN(xb_ld(&bar[XB_TOPGEN]) == tg, bar);
            __builtin_amdgcn_fence(__ATOMIC_ACQUIRE, "agent");
            xb_add(&bar[XB_XGEN(b.x)], 1u);
            asm volatile("s_waitcnt vmcnt(0)" ::: "memory");
        } else {
            XB_SPIN(xb_ld(&bar[XB_XGEN(b.x)]) == gen, bar);
            __builtin_amdgcn_fence(__ATOMIC_ACQUIRE, "agent");
            asm volatile("s_waitcnt vmcnt(0)" ::: "memory");
        }
    }
    __syncthreads();
}

__device__ __forceinline__ int seq_of_row(int r) { return r < MP ? (r >> 12) : NBP + ((r - MP) >> 5); }

template <bool ROPEPERM>
__device__ __forceinline__ void p0_transpose_item(const float* W, int K, int N, bf16_t* WT, LAS float* scr, int item, int lane) {
    const int nblk = N / 32, kb = item / nblk, nb = item % nblk, k0 = 64 * kb, n0 = 32 * nb;
#pragma unroll 8
    for (int i = 0; i < 32; ++i) { const int kk = 2 * i + (lane >> 5); scr[kk * 33 + (lane & 31)] = W[(size_t)(k0 + kk) * N + n0 + (lane & 31)]; }
    asm volatile("s_waitcnt lgkmcnt(0)" ::: "memory");
    const int c = lane & 7;
#pragma unroll
    for (int j = 0; j < 4; ++j) { const int n = (lane >> 3) + 8 * j; const LAS float* s = scr + (8 * c) * 33 + n;
        u32x4 o; o.x = cvt_pk_bf16(s[0 * 33], s[1 * 33]); o.y = cvt_pk_bf16(s[2 * 33], s[3 * 33]); o.z = cvt_pk_bf16(s[4 * 33], s[5 * 33]); o.w = cvt_pk_bf16(s[6 * 33], s[7 * 33]);
        int nn = n0 + n;
        if (ROPEPERM) nn = (nn & ~255) + 128 * ((nn >> 5) & 1) + 32 * ((nn >> 6) & 3) + (nn & 31);
        *(u32x4*)(WT + (size_t)nn * K + k0 + 8 * c) = o; }
    asm volatile("s_waitcnt lgkmcnt(0)" ::: "memory");
}

struct Args { const float* in[21]; float* out; unsigned char* ws; int ph_lo, ph_hi; };

template <int W>
__device__ __forceinline__ void pool_item(const float* xs, const float* rstd, bf16_t* P, int t0, int tend, bool sample, const float* prefix, float* pool_out, int pool_t0, const f32x4 a, const f32x4 b, int c) {
    f32x4 ring[W];
#pragma unroll
    for (int i = 0; i < W; ++i) ring[i] = (f32x4){0.f, 0.f, 0.f, 0.f};
    f32x4 s = (f32x4){0.f, 0.f, 0.f, 0.f};
    const int tstart = sample ? -16 : (t0 >= 16 ? t0 - 16 : 0);
    for (int tb = tstart; tb < tend; tb += 16) {
#pragma unroll
        for (int i = 0; i < 16; ++i) {
            const int t = tb + i;
            f32x4 h;
            if (t < 0) { h = (t >= -15) ? *(const f32x4*)(prefix + (size_t)(t + 15) * D + c) : (f32x4){0.f, 0.f, 0.f, 0.f}; }
            else { const f32x4 xv = *(const f32x4*)(xs + (size_t)t * D + c); const float rs = rstd[t]; h = xv * rs * a + b; }
            s = s + h - ring[i % W]; ring[i % W] = h;
            if (t >= t0) {
                const float inv = sample ? (1.0f / W) : ((t + 1 < W) ? 1.0f / (float)(t + 1) : (1.0f / W));
                const f32x4 p = s * inv - h;
                u32x2 w; w.x = cvt_pk_bf16(p[0], p[1]); w.y = cvt_pk_bf16(p[2], p[3]);
                *(u32x2*)(P + (size_t)t * D + c) = w;
                if (t >= pool_t0) *(f32x4*)(pool_out + (size_t)(t - pool_t0) * D + c) = h;
            }
        }
    }
}

template <int NOUT>
__device__ __forceinline__ void row_tail(LAS const float* cs, const f32x4 (&y)[8], f32x4 (&x)[8], int r, int lane, float* X, bf16_t* H0, bf16_t* H1, float* rstd_out) {
    float ss = 0.f;
#pragma unroll
    for (int j = 0; j < 8; ++j) ss += (y[j][0] * y[j][0] + y[j][1] * y[j][1]) + (y[j][2] * y[j][2] + y[j][3] * y[j][3]);
    const float ry = rsqrtf(wave_sum(ss) * (1.0f / D) + EPS);
    float sx = 0.f;
#pragma unroll
    for (int j = 0; j < 8; ++j) { const f32x4 cg = *(LAS const f32x4*)(cs + 4 * lane + 256 * j);
        x[j] = x[j] + cg * (y[j] * ry); sx += (x[j][0] * x[j][0] + x[j][1] * x[j][1]) + (x[j][2] * x[j][2] + x[j][3] * x[j][3]);
        *(f32x4*)(X + (size_t)r * D + 4 * lane + 256 * j) = x[j]; }
    if (NOUT >= 1 || rstd_out) {
        const float rx = rsqrtf(wave_sum(sx) * (1.0f / D) + EPS);
        if (rstd_out && lane == 0) rstd_out[r] = rx;
        if (NOUT >= 1) {
#pragma unroll
            for (int j = 0; j < 8; ++j) { const f32x4 a = *(LAS const f32x4*)(cs + 1 * D + 4 * lane + 256 * j), b = *(LAS const f32x4*)(cs + 2 * D + 4 * lane + 256 * j);
                const f32x4 h = x[j] * rx * a + b; u32x2 w; w.x = cvt_pk_bf16(h[0], h[1]); w.y = cvt_pk_bf16(h[2], h[3]);
                *(u32x2*)(H0 + (size_t)r * D + 4 * lane + 256 * j) = w; }
        }
        if (NOUT >= 2) {
#pragma unroll
            for (int j = 0; j < 8; ++j) { const f32x4 a = *(LAS const f32x4*)(cs + 3 * D + 4 * lane + 256 * j), b = *(LAS const f32x4*)(cs + 4 * D + 4 * lane + 256 * j);
                const f32x4 h = x[j] * rx * a + b; u32x2 w; w.x = cvt_pk_bf16(h[0], h[1]); w.y = cvt_pk_bf16(h[2], h[3]);
                *(u32x2*)(H1 + (size_t)r * D + 4 * lane + 256 * j) = w; }
        }
    }
}
template <int NOUT>
__device__ __forceinline__ void row_phase(LAS unsigned char* lds, int tid, int wave, int lane, const bf16_t* Y, const float* slab, int NS, const float* xp, const float* xs, float* X,
                                          const float* gpost, const float* gate  , int gld,
                                          bf16_t* H0, const float* g0, const float* sh0, const float* sc0, int ld0,
                                          bf16_t* H1, const float* g1, const float* sh1, const float* sc1, int ld1,
                                          float* rstd_out) {
    const int b = blockIdx.x;
    LAS float* cst = (LAS float*)lds;
    {
        const int c = 4 * tid;
#pragma unroll
        for (int set = 0; set < 2; ++set) {
            const int s = set == 0 ? (b >> 6) : NBP + (b >> 4);
            LAS float* cs = cst + set * 5 * D;
            *(LAS f32x4*)(cs + c) = *(const f32x4*)(gate + (size_t)s * gld + c) * *(const f32x4*)(gpost + c);
            if (NOUT >= 1) { *(LAS f32x4*)(cs + 1 * D + c) = *(const f32x4*)(g0 + c) * (*(const f32x4*)(sc0 + (size_t)s * ld0 + c) + 1.0f); *(LAS f32x4*)(cs + 2 * D + c) = *(const f32x4*)(sh0 + (size_t)s * ld0 + c); }
            if (NOUT >= 2) { *(LAS f32x4*)(cs + 3 * D + c) = *(const f32x4*)(g1 + c) * (*(const f32x4*)(sc1 + (size_t)s * ld1 + c) + 1.0f); *(LAS f32x4*)(cs + 4 * D + c) = *(const f32x4*)(sh1 + (size_t)s * ld1 + c); }
        }
    }
    __syncthreads();
    {
        f32x4 x[8]; u32x2 yw[8];
        { const int r = 64 * b + wave;
#pragma unroll
          for (int j = 0; j < 8; ++j) { x[j] = *(const f32x4*)(xp + (size_t)r * D + 4 * lane + 256 * j); yw[j] = *(const u32x2*)(Y + (size_t)r * D + 4 * lane + 256 * j); } }
        for (int it = 0; it < 8; ++it) {
            const int r = 64 * b + wave + 8 * it;
            f32x4 xn[8]; u32x2 ywn[8];
            if (it + 1 < 8) {
#pragma unroll
                for (int j = 0; j < 8; ++j) { xn[j] = *(const f32x4*)(xp + (size_t)(r + 8) * D + 4 * lane + 256 * j); ywn[j] = *(const u32x2*)(Y + (size_t)(r + 8) * D + 4 * lane + 256 * j); }
            }
            f32x4 y[8];
#pragma unroll
            for (int j = 0; j < 8; ++j) y[j] = (f32x4){bf_lo(yw[j].x), bf_hi(yw[j].x), bf_lo(yw[j].y), bf_hi(yw[j].y)};
            row_tail<NOUT>(cst, y, x, r, lane, X, H0, H1, rstd_out);
            if (it + 1 < 8) {
#pragma unroll
                for (int j = 0; j < 8; ++j) { x[j] = xn[j]; yw[j] = ywn[j]; }
            }
        }
    }
    if (wave < 2) {
        const int r = MP + 2 * b + wave;
        f32x4 x[8], y[8];
#pragma unroll
        for (int j = 0; j < 8; ++j) { x[j] = *(const f32x4*)(xs + (size_t)(r - MP) * D + 4 * lane + 256 * j); y[j] = (f32x4){0.f, 0.f, 0.f, 0.f}; }
        for (int k = 0; k < NS; ++k) { const float* sr = slab + ((size_t)k * MS + (r - MP)) * D + 4 * lane;
#pragma unroll
            for (int j = 0; j < 8; ++j) y[j] += *(const f32x4*)(sr + 256 * j); }
        row_tail<NOUT>(cst + 5 * D, y, x, r, lane, X, H0, H1, rstd_out);
    }
    __syncthreads();
}

__device__ __forceinline__ void attn_wave(const bf16_t* Qp  , bf16_t* Op, const bf16_t* Kb, const bf16_t* VT, int vstr, int npairs, int kfirst, int kstep_pair, bool sample, float sink2, int lane) {
    const int li = lane & 15, g = lane >> 4;
    bf16x8 qf[2][2];
#pragma unroll
    for (int qb = 0; qb < 2; ++qb)
#pragma unroll
        for (int ks = 0; ks < 2; ++ks) qf[qb][ks] = *(const bf16x8*)(Qp + (size_t)(16 * qb + li) * D + 32 * ks + 8 * g);
    f32x4 st[6][2][2];
#pragma unroll
    for (int p = 0; p < 6; ++p) {
        if (p < npairs) {
            const int k0 = sample ? (p == 0 ? 128 : 32 * (p - 1)) : kfirst - p * 32;
#pragma unroll
            for (int kh = 0; kh < 2; ++kh) {
                const bf16_t* kr = Kb + (size_t)(k0 + 16 * kh + li) * KVW + 8 * g;
                const bf16x8 kf0 = *(const bf16x8*)kr, kf1 = *(const bf16x8*)(kr + 32);
#pragma unroll
                for (int qb = 0; qb < 2; ++qb) {
                    f32x4 c = (f32x4){0.f, 0.f, 0.f, 0.f};
                    c = __builtin_amdgcn_mfma_f32_16x16x32_bf16(kf0, qf[qb][0], c, 0, 0, 0);
                    c = __builtin_amdgcn_mfma_f32_16x16x32_bf16(kf1, qf[qb][1], c, 0, 0, 0);
                    st[p][kh][qb] = c;
                }
            }
        }
    }
    (void)kstep_pair;
    float mx[2] = {sink2, sink2};
#pragma unroll
    for (int p = 0; p < 6; ++p) if (p < npairs) {
#pragma unroll
        for (int kh = 0; kh < 2; ++kh)
#pragma unroll
            for (int qb = 0; qb < 2; ++qb) { const f32x4 c = st[p][kh][qb]; mx[qb] = fmaxf(mx[qb], fmaxf(fmaxf(c[0], c[1]), fmaxf(c[2], c[3]))); }
    }
#pragma unroll
    for (int qb = 0; qb < 2; ++qb) { mx[qb] = fmaxf(mx[qb], __shfl_xor(mx[qb], 16)); mx[qb] = fmaxf(mx[qb], __shfl_xor(mx[qb], 32)); }
    float ls[2] = {0.f, 0.f};
    f32x4 o[4][2];
#pragma unroll
    for (int db = 0; db < 4; ++db)
#pragma unroll
        for (int qb = 0; qb < 2; ++qb) o[db][qb] = (f32x4){0.f, 0.f, 0.f, 0.f};
#pragma unroll
    for (int p = 0; p < 6; ++p) if (p < npairs) {
        const int k0 = sample ? (p == 0 ? 128 : 32 * (p - 1)) : kfirst - p * 32;
        bf16x8 pb[2];
#pragma unroll
        for (int qb = 0; qb < 2; ++qb) {
            float e[8];
#pragma unroll
            for (int j = 0; j < 4; ++j) { e[j] = __builtin_amdgcn_exp2f(st[p][0][qb][j] - mx[qb]); e[4 + j] = __builtin_amdgcn_exp2f(st[p][1][qb][j] - mx[qb]); }
            ls[qb] += ((e[0] + e[1]) + (e[2] + e[3])) + ((e[4] + e[5]) + (e[6] + e[7]));
            u32x4 w; w.x = cvt_pk_bf16(e[0], e[1]); w.y = cvt_pk_bf16(e[2], e[3]); w.z = cvt_pk_bf16(e[4], e[5]); w.w = cvt_pk_bf16(e[6], e[7]);
            pb[qb] = __builtin_bit_cast(bf16x8, w);
        }
#pragma unroll
        for (int db = 0; db < 4; ++db) {
            const bf16_t* vr = VT + (size_t)(16 * db + li) * vstr + k0 + 4 * g;
            const u32x2 v0 = *(const u32x2*)vr, v1 = *(const u32x2*)(vr + 16);
            const u32x4 vw = (u32x4){v0.x, v0.y, v1.x, v1.y};
            const bf16x8 vf = __builtin_bit_cast(bf16x8, vw);
#pragma unroll
            for (int qb = 0; qb < 2; ++qb) o[db][qb] = __builtin_amdgcn_mfma_f32_16x16x32_bf16(vf, pb[qb], o[db][qb], 0, 0, 0);
        }
    }
#pragma unroll
    for (int qb = 0; qb < 2; ++qb) {
        float l = ls[qb]; l += __shfl_xor(l, 16); l += __shfl_xor(l, 32);
        const float inv = 1.0f / (l + __builtin_amdgcn_exp2f(sink2 - mx[qb]));
#pragma unroll
        for (int db = 0; db < 4; ++db) { const f32x4 v = o[db][qb] * inv; u32x2 w; w.x = cvt_pk_bf16(v[0], v[1]); w.y = cvt_pk_bf16(v[2], v[3]);
            *(u32x2*)(Op + (size_t)(16 * qb + li) * D + 16 * db + 4 * g) = w; }
    }
}

__global__ void __launch_bounds__(NWAVES * 64, 2) mk_fwd(Args args) {
    extern __shared__ __attribute__((aligned(16))) unsigned char lds_raw[];
    LAS unsigned char* lds = (LAS unsigned char*)lds_raw;
    volatile LAS unsigned* MISC = (volatile LAS unsigned*)(lds + MISC_OFF);
    const int G = gridDim.x, bx = blockIdx.x;
    const int wave_s = __builtin_amdgcn_readfirstlane(threadIdx.x >> 6);
#define PH_IDS() const int tid = fresh_tid(wave_s), lane = tid & 63, wave = __builtin_amdgcn_readfirstlane(tid >> 6); (void)lane; (void)wave
#define PH_GRID() int Gp = G, bxp = bx; asm volatile("" : "+s"(Gp), "+s"(bxp))
    typedef const __attribute__((address_space(4))) Args* KArgs;
#define KA() ({ KArgs _p = (KArgs)__builtin_amdgcn_kernarg_segment_ptr(); asm volatile("" : "+s"(_p)); _p; })
#define IN(k) (KA()->in[k])
#define x_prompt IN(0)
#define x_sample IN(1)
#define c_prompt IN(2)
#define c_sample IN(3)
#define state_pool IN(4)
#define cache_k IN(5)
#define cache_v IN(6)
#define w_mod IN(7)
#define b_mod IN(8)
#define g_norm IN(9)
#define w_pool IN(10)
#define pool_scale IN(11)
#define w_kv_mod IN(12)
#define b_kv_mod IN(13)
#define g_kv IN(14)
#define w_kv IN(15)
#define w_q IN(16)
#define sinks IN(17)
#define w_o IN(18)
#define w_up IN(19)
#define w_down IN(20)
#define WSB() (KA()->ws)
#define out (KA()->out)
#define MOD ((float*)(WSB() + WS_MOD))
#define KVMOD ((float*)(WSB() + WS_KVMOD))
#define ROPE ((float*)(WSB() + WS_ROPE))
#define RSTD ((float*)(WSB() + WS_RSTD))
#define KS ((bf16_t*)(WSB() + WS_KS))
#define VTS ((bf16_t*)(WSB() + WS_VTS))
#define KP ((bf16_t*)(WSB() + WS_KP))
#define VTP ((bf16_t*)(WSB() + WS_VTP))
#define WPOOL ((bf16_t*)(WSB() + WS_WPOOL))
#define WKV ((bf16_t*)(WSB() + WS_WKV))
#define WQ ((bf16_t*)(WSB() + WS_WQ))
#define WO ((bf16_t*)(WSB() + WS_WO))
#define WUP ((bf16_t*)(WSB() + WS_WUP))
#define WDN ((bf16_t*)(WSB() + WS_WDN))
#define HB ((bf16_t*)(WSB() + WS_H))
#define QB ((bf16_t*)(WSB() + WS_Q))
#define YB ((bf16_t*)(WSB() + WS_Y))
#define HKVB ((bf16_t*)(WSB() + WS_HKV))
#define UB ((bf16_t*)(WSB() + WS_U))
#define SLAB ((float*)(WSB() + WS_SLAB))
#define X (out + O_Y)

    for (int u = threadIdx.x; u < (LDS_BYTES - LDSCTL_OFF) / 4; u += NWAVES * 64) ((LAS unsigned*)(lds + LDSCTL_OFF))[u] = 0u;
    __syncthreads();
#if !MK_MULTI
    XcdBarrier bar = xcd_barrier_post((unsigned*)(WSB() + WS_CTL) + CW_BAR, MISC + 8);
#define GRID_BAR() xcd_barrier(bar)
#else
#define GRID_BAR() do {} while (0)
#endif
    const int lo = KA()->ph_lo, hi = KA()->ph_hi;
    int ph = 0;
#ifndef MK_MASK
#define MK_MASK 0xffff
#endif
#define PHASE_ON() (lo <= ph && ph < hi)
#define PHASE_END() do { if (ph + 1 < hi && ph >= lo) GRID_BAR(); ++ph; } while (0)

    if (((MK_MASK >> 0) & 1) && PHASE_ON()) {
        PH_IDS();
        {
            LAS float* scl = (LAS float*)lds;
            LAS f32x4* red = (LAS f32x4*)lds;
            for (int cb = bx; cb < 208; cb += G) {
                const float* Wm; int ldw; const float* bias; float* outp; int ldo;
                if (cb < 192) { const int l = cb / 48, cbl = cb % 48; Wm = w_mod + (size_t)l * D * MODW + cbl * 256; ldw = MODW; bias = b_mod + l * MODW + cbl * 256; outp = MOD + (size_t)l * NSEQ * MODW + cbl * 256; ldo = MODW; }
                else { const int cbl = cb - 192; Wm = w_kv_mod + cbl * 256; ldw = 2 * D; bias = b_kv_mod + cbl * 256; outp = KVMOD + cbl * 256; ldo = 2 * D; }
                f32x4 acc[NSEQ];
#pragma unroll
                for (int s = 0; s < NSEQ; ++s) acc[s] = (f32x4){0.f, 0.f, 0.f, 0.f};
                for (int pass = 0; pass < 2; ++pass) {
                    __syncthreads();
                    for (int idx = tid; idx < NSEQ * 1024; idx += NWAVES * 64) { const int s = idx >> 10, k = idx & 1023, kk = 1024 * pass + k;
                        const float cv = (s < NBP) ? c_prompt[s * D + kk] : c_sample[(s - NBP) * D + kk];
                        scl[k * NSEQ + s] = cv / (1.0f + expf(-cv)); }
                    __syncthreads();
                    const float* wp = Wm + (size_t)(1024 * pass + wave * 128) * ldw + 4 * lane;
                    const LAS float* sp = scl + wave * 128 * NSEQ;
#pragma unroll 4
                    for (int k = 0; k < 128; ++k) {
                        const f32x4 wv = *(const f32x4*)(wp + (size_t)k * ldw);
                        const LAS f32x4* s4 = (const LAS f32x4*)(sp + k * NSEQ);
#pragma unroll
                        for (int q = 0; q < 5; ++q) { const f32x4 sv = s4[q]; acc[4 * q + 0] += wv * sv[0]; acc[4 * q + 1] += wv * sv[1]; acc[4 * q + 2] += wv * sv[2]; acc[4 * q + 3] += wv * sv[3]; }
                    }
                }
#pragma unroll
                for (int half = 0; half < 2; ++half) {
                    __syncthreads();
#pragma unroll
                    for (int s = 0; s < 10; ++s) red[(wave * 10 + s) * 64 + lane] = acc[half * 10 + s];
                    __syncthreads();
                    for (int o = tid; o < 640; o += NWAVES * 64) { const int s = o >> 6, ln = o & 63;
                        f32x4 sum = *(const f32x4*)(bias + 4 * ln);
#pragma unroll
                        for (int w = 0; w < 8; ++w) sum += red[(w * 10 + s) * 64 + ln];
                        *(f32x4*)(outp + (size_t)(half * 10 + s) * ldo + 4 * ln) = sum; }
                }
                __syncthreads();
            }
        }
        __syncthreads();
        {
            LAS float* scr = (LAS float*)(lds + wave * 16384);
            const int gw = bx * NWAVES + wave, NGW = G * NWAVES;
            constexpr int I_UP = (D / 64) * (FF / 32), I_DN = (FF / 64) * (D / 32), I_Q = (D / 64) * (D / 32), I_KV = (D / 64) * (512 / 32), I_PL = (512 / 64) * (512 / 32);
            constexpr int N_UP = 4 * I_UP, N_DN = 4 * I_DN, N_Q = 2 * I_Q, N_O = 2 * I_Q, N_KV = I_KV, N_PL = 8 * I_PL;
            constexpr int NITEMS = N_UP + N_DN + N_Q + N_O + N_KV + N_PL;
            for (int it = gw; it < NITEMS; it += NGW) {
                int r = it;
                if (r < N_UP) { const int l = r / I_UP; p0_transpose_item<false>(w_up + (size_t)l * D * FF, D, FF, WUP + (size_t)l * FF * D, scr, r % I_UP, lane); continue; } r -= N_UP;
                if (r < N_DN) { const int l = r / I_DN; p0_transpose_item<false>(w_down + (size_t)l * FF * D, FF, D, WDN + (size_t)l * D * FF, scr, r % I_DN, lane); continue; } r -= N_DN;
                if (r < N_Q) { const int j = r / I_Q; p0_transpose_item<true>(w_q + (size_t)j * D * D, D, D, WQ + (size_t)j * D * D, scr, r % I_Q, lane); continue; } r -= N_Q;
                if (r < N_O) { const int j = r / I_Q; p0_transpose_item<false>(w_o + (size_t)j * D * D, D, D, WO + (size_t)j * D * D, scr, r % I_Q, lane); continue; } r -= N_O;
                if (r < N_KV) { const int nb = r % 16;
                    if (nb < 8) p0_transpose_item<true>(w_kv, D, 512, WKV, scr, r, lane); else p0_transpose_item<false>(w_kv, D, 512, WKV, scr, r, lane); continue; } r -= N_KV;
                { const int lg = r / I_PL; p0_transpose_item<false>(w_pool + (size_t)lg * 512 * 512, 512, 512, WPOOL + (size_t)lg * 512 * 512, scr, r % I_PL, lane); }
            }
            for (int r = gw; r < M; r += NGW) {
                const float* xr = (r < MP) ? x_prompt + (size_t)r * D : x_sample + (size_t)(r - MP) * D;
                float ss = 0.f;
#pragma unroll
                for (int j = 0; j < 8; ++j) { const f32x4 v = *(const f32x4*)(xr + 4 * lane + 256 * j); ss += (v[0] * v[0] + v[1] * v[1]) + (v[2] * v[2] + v[3] * v[3]); }
                ss = wave_sum(ss);
                if (lane == 0) RSTD[r] = rsqrtf(ss * (1.0f / D) + EPS);
            }
            const int gt = bx * (NWAVES * 64) + tid, NGT = G * NWAVES * 64;
            for (int idx = gt; idx < NPOS * 32; idx += NGT) {
                const int pos = idx >> 5, i = idx & 31;
                double inv = 1.0; for (int q = 0; q < i; ++q) inv *= 0.74989420933245582730;
                const float ang = (float)pos * (float)inv;
                const double a = (double)ang;
                const double kq = __builtin_rint(a * 0.15915494309189533577);
                double rr = a - kq * 6.28318530717958623200; rr = rr - kq * 2.4492935982947064e-16;
                const double r2 = rr * rr;
                double sn = 0.0, cs = 0.0;
#pragma unroll
                for (int n = 14; n >= 0; --n) { sn = sn * (-r2) / (double)((2 * n + 2) * (2 * n + 3)) + 1.0; cs = cs * (-r2) / (double)((2 * n + 1) * (2 * n + 2)) + 1.0; }
                sn *= rr;
                ROPE[2 * idx] = (float)cs; ROPE[2 * idx + 1] = (float)sn;
            }
            for (int idx = gt; idx < NBS * 128 * KVW; idx += NGT) {
                const int sb = idx / (128 * KVW), rem = idx % (128 * KVW), key = rem / KVW, col = rem % KVW;
                const unsigned kw = cvt_pk_bf16(cache_k[idx], 0.f);
                KS[((size_t)sb * SKEYS + key) * KVW + col] = (bf16_t)(kw & 0xffff);
                const unsigned vw = cvt_pk_bf16(cache_v[idx], 0.f);
                VTS[((size_t)sb * KVW + col) * SKEYS + key] = (bf16_t)(vw & 0xffff);
            }
        }
    }
    PHASE_END();

    for (int l = 0; l < DEPTH; ++l) {
#define modl (MOD + (size_t)l * NSEQ * MODW)
#define gn (g_norm + (size_t)l * 4 * D)
        if (l < NA) {
            if (((MK_MASK >> 1) & 1) && PHASE_ON()) {
                PH_IDS();
                const int c = 4 * tid;
                const f32x4 gv = *(const f32x4*)(gn + c);
                for (int it = bx; it < 256 + NBS; it += G) {
                    const bool sample = it >= 256;
                    int s, t0, tend, pool_t0; const float* xsrc; const float* rs; bf16_t* P; const float* prefix = nullptr; float* pout;
                    if (!sample) { const int b = it >> 6; s = b; t0 = (it & 63) * 64; tend = t0 + 64; pool_t0 = SEQ - 15;
                        xsrc = (l == 0 ? x_prompt : X) + (size_t)b * SEQ * D; rs = RSTD + b * SEQ; P = HB + (size_t)b * SEQ * D; pout = out + O_PP + ((size_t)(l * NBP + b) * 15) * D; }
                    else { const int sb = it - 256; s = NBP + sb; t0 = 0; tend = DSEQ; pool_t0 = DSEQ - 15;
                        xsrc = (l == 0 ? x_sample : X + (size_t)MP * D) + (size_t)sb * DSEQ * D; rs = RSTD + MP + sb * DSEQ; P = HB + (size_t)(MP + sb * DSEQ) * D;
                        prefix = state_pool + ((size_t)(l * NBS + sb) * 15) * D; pout = out + O_PS + ((size_t)(l * NBS + sb) * 15) * D; }
                    const float* ms = modl + (size_t)s * MODW;
                    const f32x4 a = gv * (*(const f32x4*)(ms + 1 * D + c) + 1.0f), b = *(const f32x4*)(ms + 0 * D + c);
                    switch (wave >> 1) {
                        case 0: pool_item<2>(xsrc, rs, P, t0, tend, sample, prefix, pout, pool_t0, a, b, c); break;
                        case 1: pool_item<4>(xsrc, rs, P, t0, tend, sample, prefix, pout, pool_t0, a, b, c); break;
                        case 2: pool_item<8>(xsrc, rs, P, t0, tend, sample, prefix, pout, pool_t0, a, b, c); break;
                        default: pool_item<16>(xsrc, rs, P, t0, tend, sample, prefix, pout, pool_t0, a, b, c); break;
                    }
                }
            }
            PHASE_END();
            if (((MK_MASK >> 2) & 1) && PHASE_ON()) {
                PH_GRID();
                pg8::SchedSplit S{(const char*)HB, (const char*)(WPOOL + (size_t)l * D * 512), D, 512, 8, 8, 4, 2, Gp, bxp, true};
                pg8::EpiSplit<2> E{YB, SLAB, pool_scale + (size_t)l * D};
                pg8::gemm_phase(lds, wave_s, D, 512, S, E);
            }
            PHASE_END();
        } else {
            const int j = l - NA;
            if (((MK_MASK >> 3) & 1) && PHASE_ON()) {
                PH_GRID();
                pg8::SchedQKV S{(const char*)WSB(), j, M / 256, (j == 0) ? 10 : 8, Gp, bxp};
                pg8::EpiQKV E{WSB(), out};
                pg8::gemm_phase(lds, wave_s, D, D, S, E);
            }
            PHASE_END();
            if (((MK_MASK >> 4) & 1) && PHASE_ON()) {
                PH_IDS();
                for (int it = bx; it < 1024 + 64; it += G) {
                    if (it < 1024) {
                        const int kh = it & 3, n = (it >> 2) & 63, b = it >> 8, h = kh * 8 + wave;
                        const float sink2 = sinks[j * NH + h] * LOG2E;
                        const bf16_t* Kb = KP + (size_t)b * SEQ * KVW + kh * HD; const bf16_t* VT = VTP + (size_t)(b * NKV + kh) * HD * SEQ;
                        const int npairs = 2 * (n < 2 ? n + 1 : 3), kfirst = n * 64 + 32;
#pragma unroll 1
                        for (int hf = 0; hf < 2; ++hf) {
                            const size_t row = (size_t)b * SEQ + n * 64 + hf * 32;
                            attn_wave(QB + row * D + h * HD, QB + row * D + h * HD, Kb, VT, SEQ, npairs, kfirst, 0, false, sink2, lane);
                        }
                    } else {
                        const int u = it - 1024, sb = u >> 2, kh = u & 3, h = kh * 8 + wave;
                        const float sink2 = sinks[j * NH + h] * LOG2E;
                        const bf16_t* Kb = KS + (size_t)sb * SKEYS * KVW + kh * HD; const bf16_t* VT = VTS + (size_t)(sb * NKV + kh) * HD * SKEYS;
                        const size_t row = (size_t)MP + sb * DSEQ;
                        attn_wave(QB + row * D + h * HD, QB + row * D + h * HD, Kb, VT, SKEYS, 5, 0, 0, true, sink2, lane);
                    }
                }
            }
            PHASE_END();
            if (((MK_MASK >> 5) & 1) && PHASE_ON()) {
                PH_GRID();
                pg8::SchedSplit S{(const char*)QB, (const char*)(WO + (size_t)j * D * D), D, D, 8, D / 64, 16, 2, Gp, bxp, false};
                pg8::EpiSplit<0> E{YB, SLAB, nullptr};
                pg8::gemm_phase(lds, wave_s, D, D, S, E);
            }
            PHASE_END();
        }
        if (((MK_MASK >> 6) & 1) && PHASE_ON()) {
            PH_IDS();
            const float* xp = (l == 0) ? x_prompt : X; const float* xs = (l == 0) ? x_sample : X + (size_t)MP * D;
            row_phase<1>(lds, tid, wave, lane, YB, SLAB, (l < NA) ? 4 : 16, xp, xs, X, gn + 1 * D, modl + 2 * D, MODW, HB, gn + 2 * D, modl + 3 * D, modl + 4 * D, MODW, nullptr, nullptr, nullptr, nullptr, 0, nullptr);
        }
        PHASE_END();
        if (((MK_MASK >> 7) & 1) && PHASE_ON()) {
            PH_GRID();
            pg8::SchedMN S{(const char*)HB, (const char*)(WUP + (size_t)l * FF * D), D, D, M / 256, FF / 256, D / 64, Gp, bxp};
            pg8::EpiBf16<1> E{UB, FF, nullptr};
            pg8::gemm_phase(lds, wave_s, D, D, S, E);
        }
        PHASE_END();
        if (((MK_MASK >> 8) & 1) && PHASE_ON()) {
            PH_GRID();
            pg8::SchedSplit S{(const char*)UB, (const char*)(WDN + (size_t)l * D * FF), FF, FF, 8, FF / 64, 16, 8, Gp, bxp, false};
            pg8::EpiSplit<0> E{YB, SLAB, nullptr};
            pg8::gemm_phase(lds, wave_s, FF, FF, S, E);
        }
        PHASE_END();
        if (((MK_MASK >> 9) & 1) && PHASE_ON()) {
            PH_IDS();
            const float* xp = X; const float* xs = X + (size_t)MP * D;
            if (l == 0) {
                row_phase<0>(lds, tid, wave, lane, YB, SLAB, 16, xp, xs, X, gn + 3 * D, modl + 5 * D, MODW, nullptr, nullptr, nullptr, nullptr, 0, nullptr, nullptr, nullptr, nullptr, 0, RSTD);
            } else if (l == 1) {
                const float* modn = MOD + (size_t)(l + 1) * NSEQ * MODW; const float* gnn = g_norm + (size_t)(l + 1) * 4 * D;
                row_phase<2>(lds, tid, wave, lane, YB, SLAB, 16, xp, xs, X, gn + 3 * D, modl + 5 * D, MODW, HB, gnn, modn + 0 * D, modn + 1 * D, MODW, HKVB, g_kv, KVMOD, KVMOD + D, 2 * D, nullptr);
            } else if (l == 2) {
                const float* modn = MOD + (size_t)(l + 1) * NSEQ * MODW; const float* gnn = g_norm + (size_t)(l + 1) * 4 * D;
                row_phase<1>(lds, tid, wave, lane, YB, SLAB, 16, xp, xs, X, gn + 3 * D, modl + 5 * D, MODW, HB, gnn, modn + 0 * D, modn + 1 * D, MODW, nullptr, nullptr, nullptr, nullptr, 0, nullptr);
            } else {
                row_phase<0>(lds, tid, wave, lane, YB, SLAB, 16, xp, xs, X, gn + 3 * D, modl + 5 * D, MODW, nullptr, nullptr, nullptr, nullptr, 0, nullptr, nullptr, nullptr, nullptr, 0, nullptr);
            }
        }
        PHASE_END();
    }
}

#undef PH_IDS
#undef PH_GRID
#undef KA
#undef IN
#undef x_prompt
#undef x_sample
#undef c_prompt
#undef c_sample
#undef state_pool
#undef cache_k
#undef cache_v
#undef w_mod
#undef b_mod
#undef g_norm
#undef w_pool
#undef pool_scale
#undef w_kv_mod
#undef b_kv_mod
#undef g_kv
#undef w_kv
#undef w_q
#undef sinks
#undef w_o
#undef w_up
#undef w_down
#undef WSB
#undef out
#undef MOD
#undef KVMOD
#undef ROPE
#undef RSTD
#undef KS
#undef VTS
#undef KP
#undef VTP
#undef WPOOL
#undef WKV
#undef WQ
#undef WO
#undef WUP
#undef WDN
#undef HB
#undef QB
#undef YB
#undef HKVB
#undef UB
#undef SLAB
#undef X
#undef modl
#undef gn
extern "C" void kernel_launch(void* const* d_in, const int* in_sizes, int n_in, void* d_out, int out_size, void* d_ws, size_t ws_size, hipStream_t stream) {
    static int grid = 0;
    if (grid == 0) {
        if (n_in != 21 || (size_t)out_size != O_END || ws_size < WS_END) { fprintf(stderr, "kernel_launch: unexpected shapes (n_in %d out %d ws %zu)\n", n_in, out_size, ws_size); grid = -1; return; }
        int dev = 0, cus = 0, per_cu = 0;
        if (hipGetDevice(&dev) != hipSuccess || hipDeviceGetAttribute(&cus, hipDeviceAttributeMultiprocessorCount, dev) != hipSuccess) { grid = -1; return; }
        if (hipFuncSetAttribute((const void*)mk_fwd, hipFuncAttributeMaxDynamicSharedMemorySize, LDS_BYTES) != hipSuccess) { fprintf(stderr, "kernel_launch: hipFuncSetAttribute failed\n"); grid = -1; return; }
        if (hipOccupancyMaxActiveBlocksPerMultiprocessor(&per_cu, (const void*)mk_fwd, NWAVES * 64, LDS_BYTES) != hipSuccess || per_cu < 1)
            fprintf(stderr, "kernel_launch: occupancy query reports %d workgroups per CU\n", per_cu);
        (void)hipGetLastError();
        grid = cus;
        if (grid != 256) { fprintf(stderr, "kernel_launch: built for 256 CUs, got %d\n", cus); grid = -1; return; }
    }
    if (grid < 0) return;
    (void)in_sizes;
    if (hipMemsetAsync((char*)d_ws + WS_CTL, 0, CTL_ZERO_BYTES, stream) != hipSuccess) return;
    Args a{};
    for (int i = 0; i < 21; ++i) a.in[i] = (const float*)d_in[i];
    a.out = (float*)d_out; a.ws = (unsigned char*)d_ws;
    const int nph = 1 + 2 * 6 + 2 * 7;
#if MK_MULTI
    for (int p = 0; p < nph; ++p) { a.ph_lo = p; a.ph_hi = p + 1; hipLaunchKernelGGL(mk_fwd, dim3(grid), dim3(NWAVES * 64), LDS_BYTES, stream, a); }
#else
    a.ph_lo = 0; a.ph_hi = nph;
    hipLaunchKernelGGL(mk_fwd, dim3(grid), dim3(NWAVES * 64), LDS_BYTES, stream, a);
#endif
    const hipError_t le = hipPeekAtLastError();
    if (le != hipSuccess) fprintf(stderr, "kernel_launch: launch failed: %s\n", hipGetErrorName(le));
}
```
